# Optimizing an MI355X kernel written in HIP

```python
import math
import jax, jax.numpy as jnp
from jax import lax
import numpy as np

D_MODEL = 2048
BATCH = 4
SEQ = 4096
DEPTH = 2

D_MIX = D_MODEL
N_MIXERS = 4
GROUP_WIDTH = D_MIX // N_MIXERS
HEAD_DIM = D_MODEL // 16
N_HEADS = GROUP_WIDTH // HEAD_DIM
CHUNK = 128
CONV_WIDTH = 3
ROPE_BASE = 10000.0
MAX_POS_OFFSET = 4096
N_EXPERT_GROUPS = 4
EXPERTS_PER_GROUP = 8
N_EXPERTS = N_EXPERT_GROUPS * EXPERTS_PER_GROUP
TOP_K_EXPERT = 2
D_FF_EXPERT = D_MODEL // 2
MOE_BLOCK = 128
EPS = 1e-6

IN_WIDTHS = [
    GROUP_WIDTH, GROUP_WIDTH, GROUP_WIDTH, GROUP_WIDTH,
    GROUP_WIDTH, GROUP_WIDTH, GROUP_WIDTH, N_HEADS,
    GROUP_WIDTH, GROUP_WIDTH, GROUP_WIDTH, GROUP_WIDTH, N_HEADS, N_HEADS,
    GROUP_WIDTH, GROUP_WIDTH, GROUP_WIDTH,
]
N_IN = sum(IN_WIDTHS)
IN_SPLITS = [int(s) for s in np.cumsum(IN_WIDTHS)[:-1]]

kernel_name = "hybrid_parallel_heads_hier_moe"


def rms(t, g):
    t32 = t.astype(jnp.float32)
    n = t32 * lax.rsqrt(jnp.mean(t32 * t32, axis=-1, keepdims=True) + EPS)
    return n.astype(t.dtype) * g


def head_rms(t, g):
    B, S, W = t.shape
    return rms(t.reshape(B, S, W // HEAD_DIM, HEAD_DIM), g.reshape(-1, HEAD_DIM)).reshape(B, S, W)


def split_heads(t):
    B, S, W = t.shape
    return t.reshape(B, S, W // HEAD_DIM, HEAD_DIM).transpose(0, 2, 1, 3)


def merge_heads(t):
    B, H, S, d = t.shape
    return t.transpose(0, 2, 1, 3).reshape(B, S, H * d)


def to_chunks(t):
    B, H, S = t.shape[:3]
    return jnp.moveaxis(t.reshape(B, H, S // CHUNK, CHUNK, *t.shape[3:]), 2, 0)


def from_chunks(t):
    N, B, H, L = t.shape[:4]
    return jnp.moveaxis(t, 0, 2).reshape(B, H, N * L, *t.shape[4:])


def rope(t, positions):
    half = t.shape[-1] // 2
    inv = ROPE_BASE ** (-jnp.arange(half, dtype=jnp.float32) / half)
    ang = positions.astype(jnp.float32)[..., None] * inv
    cos = jnp.cos(ang)[:, :, None, :]
    sin = jnp.sin(ang)[:, :, None, :]
    t1 = t[..., :half].astype(jnp.float32)
    t2 = t[..., half:].astype(jnp.float32)
    return jnp.concatenate([t1 * cos - t2 * sin, t1 * sin + t2 * cos], axis=-1).astype(t.dtype)


def retention_chunkwise(q, k, v):
    B, H, S, d = q.shape
    L = CHUNK
    lg = jnp.log(1.0 - 2.0 ** (-5.0 - jnp.arange(H, dtype=jnp.float32)))
    i = jnp.arange(L, dtype=jnp.float32)
    rel = i[:, None] - i[None, :]
    intra_decay = jnp.where(rel >= 0, jnp.exp(lg[:, None, None] * jnp.maximum(rel, 0.0)), 0.0).astype(q.dtype)
    q_decay = jnp.exp(lg[:, None] * (i + 1.0))[:, :, None].astype(q.dtype)
    k_decay = jnp.exp(lg[:, None] * (L - 1.0 - i))[:, :, None].astype(k.dtype)
    chunk_decay = jnp.exp(lg * L)[:, None, None]

    def step(state, inp):
        qc, kc, vc = inp
        scores = jnp.einsum('bhid,bhjd->bhij', qc, kc) * intra_decay
        o = (jnp.einsum('bhij,bhjd->bhid', scores, vc).astype(jnp.float32)
             + jnp.einsum('bhid,bhde->bhie', (qc * q_decay).astype(jnp.float32), state))
        new_state = chunk_decay * state + jnp.einsum('bhjd,bhje->bhde', (kc * k_decay).astype(jnp.float32),
                                                     vc.astype(jnp.float32))
        return new_state, o

    s0 = jnp.zeros((B, H, d, d), jnp.float32)
    _, o = lax.scan(step, s0, (to_chunks(q), to_chunks(k), to_chunks(v)))
    return from_chunks(o).astype(q.dtype)


def forgetting_attention(q, k, v, F):
    B, H, S, d = q.shape
    scale = 1.0 / math.sqrt(d)
    kpos = jnp.arange(S)

    def block(args):
        qi, Fi, bi = args
        logits = (jnp.einsum('bhld,bhsd->bhls', qi, k).astype(jnp.float32) * scale
                  + Fi[..., None] - F[:, :, None, :])
        qpos = bi * CHUNK + jnp.arange(CHUNK)
        logits = jnp.where(kpos[None, :] <= qpos[:, None], logits, -jnp.inf)
        p = jax.nn.softmax(logits, axis=-1).astype(v.dtype)
        return jnp.einsum('bhls,bhsd->bhld', p, v)

    o = lax.map(block, (to_chunks(q), to_chunks(F), jnp.arange(S // CHUNK)))
    return from_chunks(o)


def mlstm_chunkwise(q, k, v, ig, lf):
    B, H, S, d = q.shape
    L = CHUNK
    tri = jnp.tril(jnp.ones((L, L), dtype=bool))

    def step(carry, inp):
        C, n, m = carry
        qc, kc, vc, igc, lfc = inp
        qc = qc.astype(jnp.float32)
        kc = kc.astype(jnp.float32)
        vc = vc.astype(jnp.float32)
        b = jnp.cumsum(lfc, axis=-1)
        logD = jnp.where(tri, b[..., :, None] - b[..., None, :] + igc[..., None, :], -jnp.inf)
        m_inter = b + m[..., None]
        m_t = jnp.maximum(jnp.max(logD, axis=-1), m_inter)
        s = jnp.einsum('bhid,bhjd->bhij', qc, kc) * jnp.exp(logD - m_t[..., None])
        inter = jnp.exp(m_inter - m_t)
        num = jnp.einsum('bhij,bhjd->bhid', s, vc) + inter[..., None] * jnp.einsum('bhid,bhde->bhie', qc, C)
        den = jnp.maximum(jnp.abs(jnp.sum(s, axis=-1) + inter * jnp.einsum('bhid,bhd->bhi', qc, n)),
                          jnp.exp(-m_t))
        h = num / den[..., None]
        bL = b[..., -1]
        logw = bL[..., None] - b + igc
        m_new = jnp.maximum(bL + m, jnp.max(logw, axis=-1))
        kw = kc * jnp.exp(logw - m_new[..., None])[..., None]
        decay = jnp.exp(bL + m - m_new)
        C_new = decay[..., None, None] * C + jnp.einsum('bhjd,bhje->bhde', kw, vc)
        n_new = decay[..., None] * n + jnp.sum(kw, axis=2)
        return (C_new, n_new, m_new), h

    carry0 = (jnp.zeros((B, H, d, d), jnp.float32), jnp.zeros((B, H, d), jnp.float32),
              jnp.zeros((B, H), jnp.float32))
    _, h = lax.scan(step, carry0, (to_chunks(q), to_chunks(k), to_chunks(v), to_chunks(ig), to_chunks(lf)))
    return from_chunks(h).astype(q.dtype)


def causal_depthwise_conv(u, w):
    C = u.shape[-1]
    return lax.conv_general_dilated(u, w.reshape(CONV_WIDTH, 1, C).astype(u.dtype), (1,),
                                    [(CONV_WIDTH - 1, 0)], dimension_numbers=('NWC', 'WIO', 'NWC'),
                                    feature_group_count=C)


def hier_moe(h, w_rg, b_rg, w_re, b_re, w_gate, w_up, w_down):
    B, S, D = h.shape
    T = B * S
    xt = h.reshape(T, D)
    gprob = jax.nn.softmax((xt @ w_rg + b_rg).astype(jnp.float32), axis=-1)
    gp, gsel = lax.top_k(gprob, 1)
    elog = (xt @ w_re + b_re).astype(jnp.float32).reshape(T, N_EXPERT_GROUPS, EXPERTS_PER_GROUP)
    elog = jnp.take_along_axis(elog, gsel[:, :, None], axis=1)[:, 0]
    ev, ei = lax.top_k(jax.nn.softmax(elog, axis=-1), TOP_K_EXPERT)
    wts = gp * ev / jnp.sum(ev, axis=-1, keepdims=True)
    eid = gsel * EXPERTS_PER_GROUP + ei

    A = T * TOP_K_EXPERT
    eid_f = eid.reshape(A)
    tok_f = jnp.repeat(jnp.arange(T, dtype=jnp.int32), TOP_K_EXPERT)
    w_f = wts.reshape(A)
    order = jnp.argsort(eid_f)
    se = eid_f[order]
    counts = jnp.bincount(eid_f, length=N_EXPERTS)
    starts = jnp.cumsum(counts) - counts
    pcounts = ((counts + MOE_BLOCK - 1) // MOE_BLOCK) * MOE_BLOCK
    pends = jnp.cumsum(pcounts)
    pstarts = pends - pcounts
    dest = pstarts[se] + (jnp.arange(A) - starts[se])
    P = A + N_EXPERTS * MOE_BLOCK
    n_blocks = P // MOE_BLOCK
    row_tok = jnp.zeros((P,), jnp.int32).at[dest].set(tok_f[order])
    row_w = jnp.zeros((P,), jnp.float32).at[dest].set(w_f[order])
    block_eid = jnp.minimum(jnp.searchsorted(pends, jnp.arange(n_blocks) * MOE_BLOCK, side='right'),
                            N_EXPERTS - 1)
    xs = xt[row_tok].reshape(n_blocks, MOE_BLOCK, D)

    def expert_block(args):
        xb, e = args
        return (jax.nn.silu(xb @ w_gate[e]) * (xb @ w_up[e])) @ w_down[e]

    ys = lax.map(expert_block, (xs, block_eid)).reshape(P, D)
    out = jnp.zeros((T, D), h.dtype).at[row_tok].add(ys * row_w[:, None].astype(ys.dtype))
    return out.reshape(B, S, D)


def hybrid_layer(x, positions, norm1_g, w_in, fox_f_bias, fox_q_norm, fox_k_norm, mlstm_i_bias,
                 mlstm_f_bias, conv_w, head_norm_g, w_out, norm2_g, w_rg, b_rg, w_re, b_re,
                 w_gate, w_up, w_down):
    B, S, _ = x.shape
    h = rms(x, norm1_g)
    z = h @ w_in
    (rq, rk, rv, rg, fq, fk, fv, ff, mq, mk, mv, mo, mi, mf, ch, cb, cc) = jnp.split(z, IN_SPLITS, axis=-1)
    g_ret, g_fox, g_mls, g_conv = jnp.split(head_norm_g, N_MIXERS)
    kscale = HEAD_DIM ** -0.5

    q4 = rope(rq.reshape(B, S, N_HEADS, HEAD_DIM), positions)
    k4 = rope(rk.reshape(B, S, N_HEADS, HEAD_DIM), positions) * kscale
    ret = retention_chunkwise(q4.transpose(0, 2, 1, 3), k4.transpose(0, 2, 1, 3), split_heads(rv))
    ret = jax.nn.silu(rg) * head_rms(merge_heads(ret), g_ret)

    fq4 = rms(fq.reshape(B, S, N_HEADS, HEAD_DIM), fox_q_norm).transpose(0, 2, 1, 3)
    fk4 = rms(fk.reshape(B, S, N_HEADS, HEAD_DIM), fox_k_norm).transpose(0, 2, 1, 3)
    F = jnp.cumsum(jax.nn.log_sigmoid((ff + fox_f_bias).astype(jnp.float32)), axis=1).transpose(0, 2, 1)
    fox = head_rms(merge_heads(forgetting_attention(fq4, fk4, split_heads(fv), F)), g_fox)

    ig = (mi + mlstm_i_bias).astype(jnp.float32).transpose(0, 2, 1)
    lf = jax.nn.log_sigmoid((mf + mlstm_f_bias).astype(jnp.float32)).transpose(0, 2, 1)
    hcell = mlstm_chunkwise(split_heads(mq), split_heads(mk) * kscale, split_heads(mv), ig, lf)
    mls = head_rms(jax.nn.sigmoid(mo) * merge_heads(hcell), g_mls)

    cv = head_rms(cb * causal_depthwise_conv(cc * ch, conv_w), g_conv)

    x = x + jnp.concatenate([ret, fox, mls, cv], axis=-1) @ w_out
    return x + hier_moe(rms(x, norm2_g), w_rg, b_rg, w_re, b_re, w_gate, w_up, w_down)


def setup_inputs(seed: int = 0) -> dict:
    key = jax.random.key(seed)
    ks = jax.random.split(key, 20)
    f32 = jnp.float32
    nrm = lambda k, shp, s: jax.random.normal(k, shp, f32) * s
    positions = (jax.random.randint(ks[1], (BATCH, 1), 0, MAX_POS_OFFSET, dtype=jnp.int32)
                 + jnp.arange(SEQ, dtype=jnp.int32)[None, :])
    return {
        "x": nrm(ks[0], (BATCH, SEQ, D_MODEL), 1.0),
        "positions": positions,
        "norm1_g": 1.0 + nrm(ks[2], (DEPTH, D_MODEL), 0.02),
        "w_in": nrm(ks[3], (DEPTH, D_MODEL, N_IN), D_MODEL ** -0.5),
        "fox_f_bias": jax.random.uniform(ks[4], (DEPTH, N_HEADS), f32, 1.0, 3.0),
        "fox_q_norm": 1.0 + nrm(ks[5], (DEPTH, HEAD_DIM), 0.02),
        "fox_k_norm": 1.0 + nrm(ks[6], (DEPTH, HEAD_DIM), 0.02),
        "mlstm_i_bias": nrm(ks[7], (DEPTH, N_HEADS), 0.1),
        "mlstm_f_bias": jax.random.uniform(ks[8], (DEPTH, N_HEADS), f32, 3.0, 6.0),
        "conv_w": nrm(ks[9], (DEPTH, CONV_WIDTH, GROUP_WIDTH), CONV_WIDTH ** -0.5),
        "head_norm_g": 1.0 + nrm(ks[10], (DEPTH, D_MIX), 0.02),
        "w_out": nrm(ks[11], (DEPTH, D_MIX, D_MODEL), D_MIX ** -0.5),
        "norm2_g": 1.0 + nrm(ks[12], (DEPTH, D_MODEL), 0.02),
        "w_router_group": nrm(ks[13], (DEPTH, D_MODEL, N_EXPERT_GROUPS), D_MODEL ** -0.5),
        "b_router_group": nrm(ks[14], (DEPTH, N_EXPERT_GROUPS), 0.01),
        "w_router_expert": nrm(ks[15], (DEPTH, D_MODEL, N_EXPERTS), D_MODEL ** -0.5),
        "b_router_expert": nrm(ks[16], (DEPTH, N_EXPERTS), 0.01),
        "w_gate": nrm(ks[17], (DEPTH, N_EXPERTS, D_MODEL, D_FF_EXPERT), D_MODEL ** -0.5),
        "w_up": nrm(ks[18], (DEPTH, N_EXPERTS, D_MODEL, D_FF_EXPERT), D_MODEL ** -0.5),
        "w_down": nrm(ks[19], (DEPTH, N_EXPERTS, D_FF_EXPERT, D_MODEL), D_FF_EXPERT ** -0.5),
    }


def reference(x, positions, norm1_g, w_in, fox_f_bias, fox_q_norm, fox_k_norm, mlstm_i_bias,
              mlstm_f_bias, conv_w, head_norm_g, w_out, norm2_g, w_router_group, b_router_group,
              w_router_expert, b_router_expert, w_gate, w_up, w_down):
    for l in range(DEPTH):
        x = hybrid_layer(x, positions, norm1_g[l], w_in[l], fox_f_bias[l], fox_q_norm[l], fox_k_norm[l],
                         mlstm_i_bias[l], mlstm_f_bias[l], conv_w[l], head_norm_g[l], w_out[l], norm2_g[l],
                         w_router_group[l], b_router_group[l], w_router_expert[l], b_router_expert[l],
                         w_gate[l], w_up[l], w_down[l])
    return x
```

```cpp
#include <hip/hip_runtime.h>
#include <cstdio>
#include <cstdint>

#ifndef MK_PER_PHASE
#define MK_PER_PHASE 0
#endif

#define GAS __attribute__((address_space(1)))
#define LAS __attribute__((address_space(3)))
typedef unsigned short bf16_t;
typedef short bf16x8 __attribute__((ext_vector_type(8)));
typedef float f32x4 __attribute__((ext_vector_type(4)));
typedef float f32x2 __attribute__((ext_vector_type(2)));
typedef unsigned u32x4 __attribute__((ext_vector_type(4)));
typedef unsigned u32x2 __attribute__((ext_vector_type(2)));
#define LDS_WAIT() asm volatile("s_waitcnt lgkmcnt(0)" ::: "memory")
#define VM_WAIT() asm volatile("s_waitcnt vmcnt(0)" ::: "memory")

constexpr int DM = 2048, NBATCH = 4, SEQ = 4096, T = NBATCH * SEQ, DEPTH = 2;
constexpr int HD = 128, NH = 4, NIN = 7180, NZ = 7168;
constexpr int NE = 32, DFF = 1024, TOKCAP = T;
constexpr float EPS = 1e-6f;
constexpr int ZQ_R = 0, ZK_R = 512, ZV_R = 1024, ZG_R = 1536, ZQ_F = 2048, ZK_F = 2560, ZV_F = 3072;
constexpr int ZQ_M = 3584, ZK_M = 4096, ZV_M = 4608, ZO_M = 5120, ZH_C = 5632, ZB_C = 6144, ZC_C = 6656;
constexpr int MAXMT = T * 2 / 256 + NE;

constexpr size_t MiB = 1u << 20;
constexpr size_t WS_CTL = 0, CTL_ZERO_BYTES = 1 * MiB;
constexpr size_t SZ_WIN = (size_t)NZ * DM * 2, SZ_WOUT = (size_t)DM * DM * 2, SZ_WGU = (size_t)NE * 2048 * DM * 2, SZ_WD = (size_t)NE * DM * DFF * 2;
constexpr size_t WS_WIN = 1 * MiB;
constexpr size_t WS_WOUT = WS_WIN + DEPTH * SZ_WIN;
constexpr size_t WS_WGU = WS_WOUT + DEPTH * SZ_WOUT;
constexpr size_t WS_WD = WS_WGU + DEPTH * SZ_WGU;
constexpr size_t WS_GW = WS_WD + DEPTH * SZ_WD;
constexpr size_t WS_RW = WS_GW + DEPTH * 12 * DM * 4;
constexpr size_t WS_HB = WS_RW + DEPTH * 36 * DM * 4;
constexpr size_t WS_Z = WS_HB + (size_t)T * DM * 2;
constexpr size_t WS_GATES = WS_Z + (size_t)T * NZ * 2;
constexpr size_t WS_PREF = WS_GATES + (size_t)T * 12 * 4;
constexpr size_t WS_Y = WS_PREF + 4 * 16 * SEQ * 4;
constexpr size_t WS_X1 = WS_Y + (size_t)T * DM * 2;
constexpr size_t WS_HH = WS_X1 + (size_t)T * DM * 4;
constexpr size_t WS_ROUTE = WS_HH + (size_t)MAXMT * 256 * DFF * 2;
constexpr size_t WS_TOK = WS_ROUTE + (size_t)T * 32;
constexpr size_t WS_STATE = WS_TOK + (size_t)NE * TOKCAP * 4;
constexpr size_t WS_END = WS_STATE + 80 * MiB;
static_assert((size_t)MAXMT * 256 * DM * 2 <= (size_t)T * NZ * 2, "ys overlays z");
constexpr int CW_BAR = 4096;
constexpr int CW_CNT = 16384;

constexpr int RING_BYTES = 131072;
constexpr int LDSCTL_OFF = RING_BYTES;
constexpr int LDS_BYTES = 147456;
constexpr int NWAVES = 8;

__device__ __forceinline__ unsigned f2bf(float f) { unsigned u = __builtin_bit_cast(unsigned, f); return (u + 0x7fffu + ((u >> 16) & 1u)) >> 16; }
__device__ __forceinline__ unsigned pk2(float lo, float hi) { return f2bf(lo) | (f2bf(hi) << 16); }
__device__ __forceinline__ float bflo(unsigned w) { return __builtin_bit_cast(float, w << 16); }
__device__ __forceinline__ float bfhi(unsigned w) { return __builtin_bit_cast(float, w & 0xffff0000u); }
__device__ __forceinline__ float bf2f(bf16_t b) { return __builtin_bit_cast(float, (unsigned)b << 16); }
__device__ __forceinline__ float wave_sum(float v) {
#pragma unroll
    for (int o = 1; o < 64; o <<= 1) v += __shfl_xor(v, o);
    return v;
}
__device__ __forceinline__ float fast_exp(float x) { return __builtin_amdgcn_exp2f(x * 1.4426950408889634f); }
__device__ __forceinline__ float sigmoidf_(float x) { return __builtin_amdgcn_rcpf(1.0f + fast_exp(-x)); }
__device__ __forceinline__ float siluf_(float x) { return x * sigmoidf_(x); }
__device__ __forceinline__ float log_sigmoidf_(float x) { return fminf(x, 0.0f) - log1pf(__expf(-fabsf(x))); }

namespace pg8 {
constexpr int BM = 256, BK = 64, HALF = 128, HTB = HALF * BK * 2, STAGE_BYTES = 8 * HTB, NXCD = 8, WGM = 8;
__host__ __device__ __forceinline__ int lds_byte(int r, int c) { const int st = (r >> 4) * 2 + (c >> 5), rr = r & 15, cc = c & 31, ob = rr * 64 + cc * 2; return st * 1024 + (ob ^ (((ob >> 9) & 1) << 5)); }
__host__ __device__ __forceinline__ void stage_rc(int b, int& R, int& C) { const int st = b / 1024, sb = b % 1024, swz = sb ^ (((sb >> 9) & 1) << 5); R = (st >> 1) * 16 + swz / 64; C = (st & 1) * 32 + (swz % 64) / 2; }
__host__ __device__ __forceinline__ int perm32(int rho) { const int n = rho >> 4, i = rho & 15; return 8 * (i >> 2) + 4 * n + (i & 3); }

struct Unit { int pm, pn, e; };

struct StaticOrder {
    int nM, nN, nwg, G, c;
    __host__ __device__ void init(int M, int N, int G_, int c_) { nM = M / BM; nN = N / BM; nwg = nM * nN; G = G_; c = c_; }
    __host__ __device__ bool next(int i, Unit& u) const {
        const long L = (long)i * G + c; if (L >= nwg) return false;
        int wgid = (int)L; { const int q = nwg / NXCD, r = nwg % NXCD, xcd = wgid % NXCD, off = wgid / NXCD; wgid = (xcd < r ? xcd * (q + 1) : r * (q + 1) + (xcd - r) * q) + off; }
        const int nig = WGM * nN, gid = wgid / nig, fm = gid * WGM, gsz = (nM - fm) < WGM ? (nM - fm) : WGM;
        u.pm = fm + ((wgid % nig) % gsz); u.pn = (wgid % nig) / gsz; u.e = 0; return true;
    }
};
struct SchedStatic {
    StaticOrder o; const char* Bt; size_t tstepB;
    __device__ __forceinline__ bool next(int i, Unit& u) const { return o.next(i, u); }
    __device__ __forceinline__ int arow(const Unit& u, int r) const { return u.pm * BM + r; }
    __device__ __forceinline__ const char* bptr(const Unit& u) const { return Bt + (size_t)u.pn * tstepB; }
};
template <bool GATHER> struct SchedMoe {
    int G, c, MT; const LAS int* tstart; const LAS int* cnt; const int* toklist; const char* Wt; size_t estride, tstepB;
    __device__ __forceinline__ bool next(int i, Unit& u) const {
        const int L = i * G + c; if (L >= MT * 8) return false;
        u.pm = L >> 3; u.pn = L & 7; int e = 0;
        for (; e < NE - 1; ++e) if (u.pm < tstart[e + 1]) break;
        u.e = e; return true;
    }
    __device__ __forceinline__ int arow(const Unit& u, int r) const {
        if (!GATHER) return u.pm * BM + r;
        const int idx = (u.pm - tstart[u.e]) * BM + r;
        return idx < cnt[u.e] ? toklist[(size_t)u.e * TOKCAP + idx] : 0;
    }
    __device__ __forceinline__ const char* bptr(const Unit& u) const { return Wt + (size_t)u.e * estride + (size_t)u.pn * tstepB; }
};

struct EpiBf16 {
    static constexpr bool PERM = true;
    bf16_t* O; int ldc;
    __device__ __forceinline__ void operator()(const f32x4 (&acc)[2][2][4][2], const Unit& u, int wr, int wc, int fr, int fq) const {
        const int row0 = u.pm * BM + wr * 64 + fr, col0 = u.pn * BM + wc * 32 + 8 * fq;
#pragma unroll
        for (int ai = 0; ai < 2; ++ai)
#pragma unroll
            for (int m = 0; m < 4; ++m) { bf16_t* rowp = O + (size_t)(row0 + ai * HALF + m * 16) * ldc + col0;
#pragma unroll
                for (int bj = 0; bj < 2; ++bj) { const f32x4 v0 = acc[ai][bj][m][0], v1 = acc[ai][bj][m][1];
                    u32x4 w; w.x = pk2(v0[0], v0[1]); w.y = pk2(v0[2], v0[3]); w.z = pk2(v1[0], v1[1]); w.w = pk2(v1[2], v1[3]);
                    *(u32x4*)(rowp + bj * HALF) = w; } }
    }
};
struct EpiResF32 {
    static constexpr bool PERM = false;
    const float* R; float* C; int ldc;
    __device__ __forceinline__ void operator()(const f32x4 (&acc)[2][2][4][2], const Unit& u, int wr, int wc, int fr, int fq) const {
        const int row0 = u.pm * BM + wr * 64 + fr, col0 = u.pn * BM + wc * 32 + 4 * fq;
#pragma unroll
        for (int ai = 0; ai < 2; ++ai)
#pragma unroll
            for (int m = 0; m < 4; ++m) { const size_t off = (size_t)(row0 + ai * HALF + m * 16) * ldc + col0;
#pragma unroll
                for (int bj = 0; bj < 2; ++bj)
#pragma unroll
                    for (int n = 0; n < 2; ++n) { const f32x4 r = *(const f32x4*)(R + off + bj * HALF + n * 16); *(f32x4*)(C + off + bj * HALF + n * 16) = r + acc[ai][bj][m][n]; }
                asm volatile("" ::: "memory"); }
    }
};
struct EpiGateUp {
    static constexpr bool PERM = true;
    bf16_t* H;
    __device__ __forceinline__ void operator()(const f32x4 (&acc)[2][2][4][2], const Unit& u, int wr, int wc, int fr, int fq) const {
        const int row0 = u.pm * BM + wr * 64 + fr, col0 = u.pn * HALF + wc * 32 + 8 * fq;
#pragma unroll
        for (int ai = 0; ai < 2; ++ai)
#pragma unroll
            for (int m = 0; m < 4; ++m) { bf16_t* rowp = H + (size_t)(row0 + ai * HALF + m * 16) * DFF + col0;
                float o[8];
#pragma unroll
                for (int n = 0; n < 2; ++n)
#pragma unroll
                    for (int j = 0; j < 4; ++j) { const float g = acc[ai][0][m][n][j], up = acc[ai][1][m][n][j]; o[n * 4 + j] = siluf_(g) * up; }
                u32x4 w; w.x = pk2(o[0], o[1]); w.y = pk2(o[2], o[3]); w.z = pk2(o[4], o[5]); w.w = pk2(o[6], o[7]);
                *(u32x4*)rowp = w; }
    }
};

template <class Epi, class Sched>
__device__ __forceinline__ void gemm_phase(LAS unsigned char* lds, const char* Abase, const int K, const Sched& S, const Epi& E) {
    int tid = threadIdx.x; asm volatile("" : "+v"(tid));
    const int wid = __builtin_amdgcn_readfirstlane(tid >> 6), lane = tid & 63, wr = wid >> 2, wc = wid & 3, fr = lane & 15, fq = lane >> 4;
    const int nt = K / BK;
    int Ri[2]; unsigned Ci[2], voffB[2];
#pragma unroll
    for (int i = 0; i < 2; ++i) { int R, C; stage_rc(tid * 16 + i * 8192, R, C); const int Rb = Epi::PERM ? ((R & ~31) + perm32(R & 31)) : R;
        Ri[i] = R; Ci[i] = (unsigned)C * 2u; voffB[i] = (unsigned)(Rb * K + C) * 2u; }
    const unsigned rowB = (unsigned)K * 2u;
    const size_t kstep = (size_t)(BK * 2);
    const size_t hstep = (size_t)HALF * K * 2;
    const unsigned ldsw = (unsigned)wid * 1024u;
    const int aoff = lds_byte(wr * 64 + fr, fq * 8), boff = lds_byte(wc * 32 + fr, fq * 8);
#define PG8_SA(b, h) (((b) * 2 + (h)) * HTB)
#define PG8_SB(b, h) ((4 + (b) * 2 + (h)) * HTB)
#define PG8_STAGE(bufoff, gbase, voff) do { _Pragma("unroll") for (int _i = 0; _i < 2; ++_i) \
        __builtin_amdgcn_global_load_lds((const unsigned*)((const char*)(gbase) + (voff)[_i]), (LAS unsigned*)(lds + (bufoff) + ldsw + _i * 8192), 16, 0, 0); } while (0)
#define PG8_LDA(dst, b, h) do { _Pragma("unroll") for (int m = 0; m < 4; ++m) _Pragma("unroll") for (int k = 0; k < 2; ++k) dst[m][k] = *(const LAS bf16x8*)(lds + PG8_SA(b, h) + aoff + m * 2048 + k * 1024); } while (0)
#define PG8_LDB(dst, b, h) do { _Pragma("unroll") for (int n = 0; n < 2; ++n) _Pragma("unroll") for (int k = 0; k < 2; ++k) dst[n][k] = *(const LAS bf16x8*)(lds + PG8_SB(b, h) + boff + n * 2048 + k * 1024); } while (0)
#define PG8_MMA(ai, bj, At, Bt) do { __builtin_amdgcn_s_setprio(1); _Pragma("unroll") for (int m = 0; m < 4; ++m) _Pragma("unroll") for (int n = 0; n < 2; ++n) _Pragma("unroll") for (int k = 0; k < 2; ++k) \
        acc[ai][bj][m][n] = __builtin_amdgcn_mfma_f32_16x16x32_bf16(Bt[n][k], At[m][k], acc[ai][bj][m][n], 0, 0, 0); __builtin_amdgcn_s_setprio(0); } while (0)
#define PG8_WAIT_V(n) asm volatile("s_waitcnt vmcnt(" #n ")" ::: "memory")
#define PG8_WAIT_L(n) asm volatile("s_waitcnt lgkmcnt(" #n ")" ::: "memory")
#define PG8_BAR __builtin_amdgcn_s_barrier()
#define PG8_SCHED __builtin_amdgcn_sched_barrier(0)
#define PG8_AOFF(dst, u) do { _Pragma("unroll") for (int _h = 0; _h < 2; ++_h) _Pragma("unroll") for (int _i = 0; _i < 2; ++_i) \
        dst[_h][_i] = (unsigned)S.arow(u, _h * HALF + Ri[_i]) * rowB + Ci[_i]; } while (0)
    Unit cur, nxt; int ui = 0;
    if (!S.next(0, cur)) return;
    f32x4 acc[2][2][4][2];
#pragma unroll
    for (int a = 0; a < 2; ++a)
#pragma unroll
        for (int b = 0; b < 2; ++b)
#pragma unroll
            for (int m = 0; m < 4; ++m)
#pragma unroll
                for (int n = 0; n < 2; ++n) acc[a][b][m][n] = (f32x4){0.f, 0.f, 0.f, 0.f};
    bf16x8 At[4][2], B0[2][2], B1[2][2];
    unsigned ac[2][2], an[2][2];
    PG8_AOFF(ac, cur);
    const char* cB = S.bptr(cur);
    PG8_STAGE(PG8_SB(0, 0), cB, voffB); PG8_STAGE(PG8_SB(0, 1), cB + hstep, voffB); PG8_STAGE(PG8_SA(0, 0), Abase, ac[0]); PG8_STAGE(PG8_SA(0, 1), Abase, ac[1]);
    if (wr == 1) PG8_BAR;
    PG8_WAIT_V(2); PG8_BAR;
    PG8_STAGE(PG8_SB(1, 0), cB + kstep, voffB); PG8_STAGE(PG8_SA(1, 0), Abase + kstep, ac[0]); PG8_STAGE(PG8_SB(1, 1), cB + hstep + kstep, voffB);
    PG8_WAIT_V(6); PG8_BAR;
    for (;;) {
        const bool has_next = S.next(ui + 1, nxt);
        const char* nB = cB;
        if (has_next) { PG8_AOFF(an, nxt); nB = S.bptr(nxt); }
        else {
#pragma unroll
            for (int h = 0; h < 2; ++h)
#pragma unroll
                for (int i = 0; i < 2; ++i) an[h][i] = ac[h][i]; }
        for (int t = 0; t < nt; t += 2) {
            const bool last = (t == nt - 2);
            const char* a1 = Abase + (size_t)(t + 1) * kstep;
            const char* a2 = last ? Abase : Abase + (size_t)(t + 2) * kstep; const char* b2 = last ? nB : cB + (size_t)(t + 2) * kstep;
            const char* a3 = a2 + kstep; const char* b3 = b2 + kstep;
            unsigned a2o[2][2];
#pragma unroll
            for (int h = 0; h < 2; ++h)
#pragma unroll
                for (int i = 0; i < 2; ++i) a2o[h][i] = last ? an[h][i] : ac[h][i];
            PG8_LDB(B0, 0, 0); PG8_LDB(B1, 0, 1); PG8_SCHED; PG8_LDA(At, 0, 0); PG8_STAGE(PG8_SA(1, 1), a1, ac[1]);
            PG8_WAIT_V(8); PG8_WAIT_L(0); PG8_BAR; PG8_MMA(0, 0, At, B0); PG8_MMA(0, 1, At, B1); PG8_BAR; PG8_SCHED;
            PG8_LDA(At, 0, 1); PG8_STAGE(PG8_SB(0, 0), b2, voffB); PG8_STAGE(PG8_SB(0, 1), b2 + hstep, voffB); PG8_STAGE(PG8_SA(0, 0), a2, a2o[0]);
            PG8_WAIT_V(8); PG8_WAIT_L(0); PG8_BAR; PG8_MMA(1, 0, At, B0); PG8_MMA(1, 1, At, B1); PG8_BAR; PG8_SCHED;
            PG8_LDB(B0, 1, 0); PG8_LDB(B1, 1, 1); PG8_SCHED; PG8_LDA(At, 1, 0); PG8_STAGE(PG8_SA(0, 1), a2, a2o[1]);
            PG8_WAIT_V(8); PG8_WAIT_L(0); PG8_BAR; PG8_MMA(0, 0, At, B0); PG8_MMA(0, 1, At, B1); PG8_BAR; PG8_SCHED;
            PG8_LDA(At, 1, 1); PG8_STAGE(PG8_SB(1, 0), b3, voffB); PG8_STAGE(PG8_SB(1, 1), b3 + hstep, voffB); PG8_STAGE(PG8_SA(1, 0), a3, a2o[0]);
            PG8_WAIT_V(8); PG8_WAIT_L(0); PG8_BAR; PG8_MMA(1, 0, At, B0); PG8_MMA(1, 1, At, B1); PG8_BAR; PG8_SCHED;
        }
        if (wr == 0) PG8_BAR;
        E(acc, cur, wr, wc, fr, fq);
        if (!has_next) break;
#pragma unroll
        for (int a = 0; a < 2; ++a)
#pragma unroll
            for (int b = 0; b < 2; ++b)
#pragma unroll
                for (int m = 0; m < 4; ++m)
#pragma unroll
                    for (int n = 0; n < 2; ++n) acc[a][b][m][n] = (f32x4){0.f, 0.f, 0.f, 0.f};
        cur = nxt; cB = nB; ++ui;
#pragma unroll
        for (int h = 0; h < 2; ++h)
#pragma unroll
            for (int i = 0; i < 2; ++i) ac[h][i] = an[h][i];
        if (wr == 1) PG8_BAR;
    }
    PG8_WAIT_V(0);
    PG8_BAR;
#undef PG8_SA
#undef PG8_SB
#undef PG8_STAGE
#undef PG8_LDA
#undef PG8_LDB
#undef PG8_MMA
#undef PG8_WAIT_V
#undef PG8_WAIT_L
#undef PG8_BAR
#undef PG8_SCHED
#undef PG8_AOFF
}
}

#define XB_TMO      128
#define XB_XCNT(j)  (256  + 64 * (j))
#define XB_XSUB(j)  (1280 + 64 * (j))
#define XB_XGEN(j)  (2304 + 64 * (j))
#define XB_TOP      3328
#define XB_TOPGEN   3392
#define XCD_BAR_WORDS 3456
#define XB_SPIN_CAP (1u << 18)
__device__ __forceinline__ unsigned xb_ld(unsigned* p)              { return __hip_atomic_load(p, __ATOMIC_RELAXED, __HIP_MEMORY_SCOPE_AGENT); }
__device__ __forceinline__ unsigned xb_add(unsigned* p, unsigned v) { return __hip_atomic_fetch_add(p, v, __ATOMIC_RELAXED, __HIP_MEMORY_SCOPE_AGENT); }
__device__ __forceinline__ unsigned xb_xcc_id() { return (unsigned)__builtin_amdgcn_s_getreg((3 << 11) | 20) & 0xFu; }
#define XB_SPIN(cond, bar) do { unsigned _sp = 0; while (cond) { __builtin_amdgcn_s_sleep(1); \
    if ((++_sp & 255u) == 0u) { if (xb_ld(&(bar)[XB_TMO])) break; if (_sp > XB_SPIN_CAP) { atomicAdd(&(bar)[XB_TMO], 1u); break; } } } } while (0)
struct XcdBarrier { unsigned* bar; unsigned x; volatile LAS unsigned* st; };
__device__ __forceinline__ XcdBarrier xcd_barrier_post(unsigned* bar, volatile LAS unsigned* st) {
    XcdBarrier b; b.bar = bar; b.x = xb_xcc_id(); b.st = st;
    if (threadIdx.x == 0) (void)xb_add(&bar[XB_XCNT(b.x)], 1u);
    return b;
}
__device__ __forceinline__ void xcd_barrier_complete(unsigned* bar, unsigned x, unsigned& nloc, unsigned& nx) {
    const unsigned G = gridDim.x * gridDim.y * gridDim.z;
    unsigned sum, cnt, mine, sp = 0u;
    for (;;) {
        sum = 0u; cnt = 0u; mine = 0u;
#pragma unroll
        for (unsigned j = 0; j < 16; ++j) { const unsigned c = xb_ld(&bar[XB_XCNT(j)]); sum += c; cnt += (c > 0u) ? 1u : 0u; mine = (j == x) ? c : mine; }
        if (sum == G) break;
        __builtin_amdgcn_s_sleep(1);
        if ((++sp & 255u) == 0u) { if (xb_ld(&bar[XB_TMO])) break; if (sp > XB_SPIN_CAP) { atomicAdd(&bar[XB_TMO], 1u); break; } }
    }
    nloc = mine > 0u ? mine : 1u; nx = cnt > 0u ? cnt : 1u;
}
__device__ __forceinline__ void xcd_barrier(const XcdBarrier& b) {
    asm volatile("s_waitcnt vmcnt(0)" ::: "memory");
    __syncthreads();
    if (threadIdx.x == 0) {
        unsigned* bar = b.bar;
        __builtin_amdgcn_s_waitcnt(0);
        unsigned nloc = b.st[0], nx = b.st[1];
        if (nloc == 0u) { xcd_barrier_complete(bar, b.x, nloc, nx); b.st[0] = nloc; b.st[1] = nx; }
        const unsigned old = xb_add(&bar[XB_XSUB(b.x)], 1u);
        const unsigned gen = old / nloc;
        if (old + 1u == (gen + 1u) * nloc) {
            __builtin_amdgcn_fence(__ATOMIC_RELEASE, "agent");
            asm volatile("s_waitcnt vmcnt(0)" ::: "memory");
            const unsigned og = xb_add(&bar[XB_TOP], 1u);
            const unsigned tg = og / nx;
            if (og + 1u == (tg + 1u) * nx) xb_add(&bar[XB_TOPGEN], 1u);
            else XB_SPIN(xb_ld(&bar[XB_TOPGEN]) == tg, bar);
            __builtin_amdgcn_fence(__ATOMIC_ACQUIRE, "agent");
            xb_add(&bar[XB_XGEN(b.x)], 1u);
            asm volatile("s_waitcnt vmcnt(0)" ::: "memory");
        } else {
            XB_SPIN(xb_ld(&bar[XB_XGEN(b.x)]) == gen, bar);
            __builtin_amdgcn_fence(__ATOMIC_ACQUIRE, "agent");
            asm volatile("s_waitcnt vmcnt(0)" ::: "memory");
        }
    }
    __syncthreads();
}

struct Params { const float* in[20]; float* out; unsigned char* ws; int ph_lo, ph_hi; };
struct Frame { LAS unsigned char* lds; int vcu, G; };
typedef const __attribute__((address_space(4))) Params* KArgs;
__device__ __forceinline__ KArgs kargs() { KArgs q = (KArgs)__builtin_amdgcn_kernarg_segment_ptr(); asm volatile("" : "+s"(q)); return q; }
#define PHASE_BEGIN() const KArgs P = kargs(); unsigned char* const ws = P->ws; int tid = threadIdx.x; asm volatile("" : "+v"(tid)); \
    const int lane = tid & 63; const int wave = __builtin_amdgcn_readfirstlane(tid >> 6); (void)lane; (void)wave; (void)ws
enum { I_X = 0, I_POS, I_N1G, I_WIN, I_FFB, I_FQN, I_FKN, I_MIB, I_MFB, I_CONVW, I_HNG, I_WOUT, I_N2G, I_WRG, I_BRG, I_WRE, I_BRE, I_WG, I_WU, I_WD };

__device__ __forceinline__ void transpose_item(const float* W, int K, int Nsrc, bf16_t* WT, int src_n0, int dst_r0, int k0, LAS float* scr, int lane) {
#pragma unroll 8
    for (int i = 0; i < 32; ++i) { const int kk = 2 * i + (lane >> 5); scr[kk * 33 + (lane & 31)] = W[(size_t)(k0 + kk) * Nsrc + src_n0 + (lane & 31)]; }
    LDS_WAIT();
    const int c = lane & 7;
#pragma unroll
    for (int j = 0; j < 4; ++j) { const int n = (lane >> 3) + 8 * j; const LAS float* s = scr + (8 * c) * 33 + n;
        u32x4 o; o.x = pk2(s[0 * 33], s[1 * 33]); o.y = pk2(s[2 * 33], s[3 * 33]); o.z = pk2(s[4 * 33], s[5 * 33]); o.w = pk2(s[6 * 33], s[7 * 33]);
        *(u32x4*)(WT + (size_t)(dst_r0 + n) * K + k0 + 8 * c) = o; }
    LDS_WAIT();
}
__device__ __forceinline__ void phase_w(Frame& F) {
    PHASE_BEGIN();
    LAS float* scr = (LAS float*)(F.lds + wave * 16384);
    const int gw = F.vcu * NWAVES + wave, NGW = F.G * NWAVES;
    constexpr int I_IN = 32 * 224, I_OUT = 32 * 64, I_EX = NE * 1024, PER_L = I_IN + I_OUT + 3 * I_EX;
    for (int it = gw; it < DEPTH * PER_L; it += NGW) {
        const int l = it / PER_L; int r = it % PER_L;
        if (r < I_IN) { const int kb = r / 224, nb = r % 224, n0 = nb * 32, src = n0 + (n0 >= 5632 ? 12 : (n0 >= 3584 ? 4 : 0));
            transpose_item(P->in[I_WIN] + (size_t)l * DM * NIN, DM, NIN, (bf16_t*)(ws + WS_WIN + l * SZ_WIN), src, n0, kb * 64, scr, lane); continue; }
        r -= I_IN;
        if (r < I_OUT) { const int kb = r / 64, nb = r % 64;
            transpose_item(P->in[I_WOUT] + (size_t)l * DM * DM, DM, DM, (bf16_t*)(ws + WS_WOUT + l * SZ_WOUT), nb * 32, nb * 32, kb * 64, scr, lane); continue; }
        r -= I_OUT;
        if (r < 2 * I_EX) { const int up = r >= I_EX; if (up) r -= I_EX;
            const int e = r >> 10, q = r & 1023, kb = q >> 5, nb = q & 31, n0 = nb * 32, dst = (n0 >> 7) * 256 + (n0 & 127) + (up ? 128 : 0);
            const float* W = P->in[up ? I_WU : I_WG] + (size_t)(l * NE + e) * DM * DFF;
            transpose_item(W, DM, DFF, (bf16_t*)(ws + WS_WGU + l * SZ_WGU) + (size_t)e * 2048 * DM, n0, dst, kb * 64, scr, lane); continue; }
        r -= 2 * I_EX;
        { const int e = r >> 10, q = r & 1023, kb = q >> 6, nb = q & 63;
            transpose_item(P->in[I_WD] + (size_t)(l * NE + e) * DFF * DM, DFF, DM, (bf16_t*)(ws + WS_WD + l * SZ_WD) + (size_t)e * DM * DFF, nb * 32, nb * 32, kb * 64, scr, lane); }
    }
    for (int idx = F.vcu * 512 + tid; idx < DEPTH * 48 * DM; idx += F.G * 512) {
        const int l = idx / (48 * DM), r = idx % (48 * DM), c = r / DM, k = r % DM;
        if (c < 12) { const int col = c < 4 ? 3584 + c : 5636 + (c - 4);
            ((float*)(ws + WS_GW))[(size_t)(l * 12 + c) * DM + k] = P->in[I_WIN][(size_t)l * DM * NIN + (size_t)k * NIN + col]; }
        else { const int cc = c - 12;
            const float v = cc < 4 ? P->in[I_WRG][((size_t)l * DM + k) * 4 + cc] : P->in[I_WRE][((size_t)l * DM + k) * 32 + (cc - 4)];
            ((float*)(ws + WS_RW))[(size_t)(l * 36 + cc) * DM + k] = v; }
    }
}

struct MoeTab { LAS int* tstart; LAS int* cnt; };
__device__ __forceinline__ MoeTab moe_tab(Frame& F, int l) {
    PHASE_BEGIN();
    MoeTab mt; mt.tstart = (LAS int*)(F.lds + LDSCTL_OFF + 1024); mt.cnt = (LAS int*)(F.lds + LDSCTL_OFF + 1024 + 256);
    const unsigned* gc = (const unsigned*)(ws + WS_CTL) + CW_CNT + l * 64;
    if (tid < NE) mt.cnt[tid] = (int)__hip_atomic_load(gc + tid, __ATOMIC_RELAXED, __HIP_MEMORY_SCOPE_AGENT);
    __syncthreads();
    if (tid == 0) { int s = 0; for (int e = 0; e < NE; ++e) { mt.tstart[e] = s; s += (mt.cnt[e] + 255) >> 8; } mt.tstart[NE] = s; }
    __syncthreads();
    return mt;
}

template <int MODE>
__device__ __forceinline__ void phase_norm1(Frame& F, int l, const float* xin, float* xout) {
    PHASE_BEGIN();
    LAS f32x4* gwl = (LAS f32x4*)F.lds;
    MoeTab mt{};
    if (MODE != 0) mt = moe_tab(F, l - 1);
    if (MODE != 2) { const f32x4* src = (const f32x4*)(ws + WS_GW + (size_t)l * 12 * DM * 4);
        for (int i = tid; i < 12 * DM / 4; i += 512) gwl[i] = src[i];
        __syncthreads(); }
    const int gw = F.vcu * NWAVES + wave, NGW = F.G * NWAVES;
    const bf16_t* ys = (const bf16_t*)(ws + WS_Z);
    const unsigned* route = (const unsigned*)(ws + WS_ROUTE);
    bf16_t* hb = (bf16_t*)(ws + WS_HB);
    float* gates = (float*)(ws + WS_GATES);
    const float* g1 = P->in[I_N1G] + (size_t)(MODE == 2 ? 0 : l) * DM;
    for (int m = gw; m < T; m += NGW) {
        const f32x4* xr = (const f32x4*)(xin + (size_t)m * DM) + lane;
        f32x4 v[8];
#pragma unroll
        for (int j = 0; j < 8; ++j) v[j] = xr[64 * j];
        if (MODE != 0) {
            const u32x4 r0 = *(const u32x4*)(route + (size_t)m * 8); const u32x2 r1 = *(const u32x2*)(route + (size_t)m * 8 + 4);
            const int s0 = mt.tstart[r0.x] * 256 + (int)r0.y, s1 = mt.tstart[r0.z] * 256 + (int)r0.w;
            const unsigned w0u = r1.x, w1u = r1.y;
            const float w0 = __builtin_bit_cast(float, w0u), w1 = __builtin_bit_cast(float, w1u);
            const u32x2* y0 = (const u32x2*)(ys + (size_t)s0 * DM) + lane; const u32x2* y1 = (const u32x2*)(ys + (size_t)s1 * DM) + lane;
#pragma unroll
            for (int j = 0; j < 8; ++j) { const u32x2 a = y0[64 * j], b = y1[64 * j];
                v[j].x += w0 * bflo(a.x) + w1 * bflo(b.x); v[j].y += w0 * bfhi(a.x) + w1 * bfhi(b.x);
                v[j].z += w0 * bflo(a.y) + w1 * bflo(b.y); v[j].w += w0 * bfhi(a.y) + w1 * bfhi(b.y); }
            f32x4* xo = (f32x4*)(xout + (size_t)m * DM) + lane;
#pragma unroll
            for (int j = 0; j < 8; ++j) xo[64 * j] = v[j];
        }
        if (MODE == 2) continue;
        float ss = 0.f;
#pragma unroll
        for (int j = 0; j < 8; ++j) ss += (v[j].x * v[j].x + v[j].y * v[j].y) + (v[j].z * v[j].z + v[j].w * v[j].w);
        const float rstd = __builtin_amdgcn_rsqf(wave_sum(ss) * (1.f / DM) + EPS);
        u32x2* o8 = (u32x2*)(hb + (size_t)m * DM) + lane;
#pragma unroll
        for (int j = 0; j < 8; ++j) { const f32x4 g = ((const f32x4*)g1)[64 * j + lane]; v[j] = v[j] * rstd * g;
            u32x2 o; o.x = pk2(v[j].x, v[j].y); o.y = pk2(v[j].z, v[j].w); o8[64 * j] = o; }
        float gs[12];
#pragma unroll
        for (int c = 0; c < 12; ++c) { float a = 0.f;
#pragma unroll
            for (int j = 0; j < 8; ++j) { const f32x4 w = gwl[c * 512 + 64 * j + lane]; a += (v[j].x * w.x + v[j].y * w.y) + (v[j].z * w.z + v[j].w * w.w); }
            gs[c] = wave_sum(a); if (c & 1) asm volatile("" ::: "memory"); }
        if (lane == 0) { f32x4* go = (f32x4*)(gates + (size_t)m * 12);
            go[0] = (f32x4){gs[0], gs[1], gs[2], gs[3]}; go[1] = (f32x4){gs[4], gs[5], gs[6], gs[7]}; go[2] = (f32x4){gs[8], gs[9], gs[10], gs[11]}; }
    }
}

__device__ __forceinline__ float block_excl_sum(int lane, int wave, float tot, LAS float* sc) {
    float inc = tot;
#pragma unroll
    for (int o = 1; o < 64; o <<= 1) { const float t = __shfl_up(inc, o); if (lane >= o) inc += t; }
    __syncthreads();
    if (lane == 63) sc[wave] = inc;
    __syncthreads();
    float base = 0.f;
    for (int w = 0; w < wave; ++w) base += sc[w];
    return base + inc - tot;
}
__device__ __forceinline__ float block_excl_max(int lane, int wave, float tot, LAS float* sc) {
    float inc = tot;
#pragma unroll
    for (int o = 1; o < 64; o <<= 1) { const float t = __shfl_up(inc, o); if (lane >= o) inc = fmaxf(inc, t); }
    __syncthreads();
    if (lane == 63) sc[wave] = inc;
    __syncthreads();
    float base = -INFINITY;
    for (int w = 0; w < wave; ++w) base = fmaxf(base, sc[w]);
    const float prev = __shfl_up(inc, 1);
    return fmaxf(base, lane == 0 ? -INFINITY : prev);
}

__device__ __forceinline__ void phase_prep(Frame& F, int l) {
    PHASE_BEGIN();
    bf16_t* z = (bf16_t*)(ws + WS_Z);
    bf16_t* y = (bf16_t*)(ws + WS_Y);
    const float* gates = (const float*)(ws + WS_GATES);
    float* pref = (float*)(ws + WS_PREF);
    for (int it = F.vcu; it < 32; it += F.G) {
        const int kind = it >> 4, bh = it & 15, b = bh >> 2, h = bh & 3;
        LAS float* sc = (LAS float*)(F.lds + 65536);
        const int s0 = tid * 8;
        float v[8], a[8];
        if (kind == 0) {
            const float fb = P->in[I_FFB][l * NH + h];
            float run = 0.f;
#pragma unroll
            for (int i = 0; i < 8; ++i) { run += log_sigmoidf_(gates[(size_t)(b * SEQ + s0 + i) * 12 + h] + fb); v[i] = run; }
            const float base = block_excl_sum(lane, wave, run, sc);
#pragma unroll
            for (int i = 0; i < 8; ++i) pref[(size_t)(0 * 16 + bh) * SEQ + s0 + i] = base + v[i];
        } else {
            const float fb = P->in[I_MFB][l * NH + h], ib = P->in[I_MIB][l * NH + h];
            float run = 0.f;
#pragma unroll
            for (int i = 0; i < 8; ++i) { run += log_sigmoidf_(gates[(size_t)(b * SEQ + s0 + i) * 12 + 8 + h] + fb); v[i] = run; }
            const float base = block_excl_sum(lane, wave, run, sc);
            float mx = -INFINITY;
#pragma unroll
            for (int i = 0; i < 8; ++i) { v[i] += base; a[i] = gates[(size_t)(b * SEQ + s0 + i) * 12 + 4 + h] + ib - v[i]; mx = fmaxf(mx, a[i]); }
            float pm = fmaxf(block_excl_max(lane, wave, mx, sc + 16), 0.f);
#pragma unroll
            for (int i = 0; i < 8; ++i) { pm = fmaxf(pm, a[i]);
                pref[(size_t)(1 * 16 + bh) * SEQ + s0 + i] = v[i]; pref[(size_t)(2 * 16 + bh) * SEQ + s0 + i] = a[i]; pref[(size_t)(3 * 16 + bh) * SEQ + s0 + i] = pm; }
        }
        __syncthreads();
    }
    const int gw = F.vcu * NWAVES + wave, NGW = F.G * NWAVES;
    const float inv = __builtin_amdgcn_exp2f(-(float)lane * (13.287712379549449f / 64.f));
    const float gq0 = P->in[I_FQN][l * HD + lane], gq1 = P->in[I_FQN][l * HD + 64 + lane], gk0 = P->in[I_FKN][l * HD + lane], gk1 = P->in[I_FKN][l * HD + 64 + lane];
    const float* cw = P->in[I_CONVW] + (size_t)l * 3 * 512; const float* gcv = P->in[I_HNG] + (size_t)l * DM + 1536;
    for (int m = gw; m < T; m += NGW) {
        bf16_t* zr = z + (size_t)m * NZ;
        const float ang = (float)((const int*)P->in[I_POS])[m] * inv;
        const float C1 = 0.15915493667125702f, C2 = 6.420638326565253e-09f;
        const float hi = ang * C1, lo = __builtin_fmaf(ang, C1, -hi);
        const float rev = (hi - __builtin_floorf(hi)) + (lo + ang * C2);
        const float cs = __builtin_amdgcn_cosf(rev), sn = __builtin_amdgcn_sinf(rev);
#pragma unroll
        for (int qk = 0; qk < 2; ++qk)
#pragma unroll
            for (int h = 0; h < NH; ++h) { bf16_t* p = zr + (qk ? ZK_R : ZQ_R) + h * HD + lane;
                const float t1 = bf2f(p[0]), t2 = bf2f(p[64]);
                p[0] = (bf16_t)f2bf(t1 * cs - t2 * sn); p[64] = (bf16_t)f2bf(t1 * sn + t2 * cs); }
#pragma unroll
        for (int qk = 0; qk < 2; ++qk)
#pragma unroll
            for (int h = 0; h < NH; ++h) { bf16_t* p = zr + (qk ? ZK_F : ZQ_F) + h * HD + lane;
                const float t1 = bf2f(p[0]), t2 = bf2f(p[64]);
                const float rstd = __builtin_amdgcn_rsqf(wave_sum(t1 * t1 + t2 * t2) * (1.f / HD) + EPS);
                p[0] = (bf16_t)f2bf(t1 * rstd * (qk ? gk0 : gq0)); p[64] = (bf16_t)f2bf(t2 * rstd * (qk ? gk1 : gq1)); }
        { const int s = m & (SEQ - 1), c0 = 8 * lane;
            float u[3][8];
#pragma unroll
            for (int d = 0; d < 3; ++d) {
                if (s - (2 - d) >= 0) { const bf16_t* zz = zr - (size_t)(2 - d) * NZ;
                    const u32x4 hc = *(const u32x4*)(zz + ZH_C + c0), cc = *(const u32x4*)(zz + ZC_C + c0);
                    u[d][0] = bflo(hc.x) * bflo(cc.x); u[d][1] = bfhi(hc.x) * bfhi(cc.x); u[d][2] = bflo(hc.y) * bflo(cc.y); u[d][3] = bfhi(hc.y) * bfhi(cc.y);
                    u[d][4] = bflo(hc.z) * bflo(cc.z); u[d][5] = bfhi(hc.z) * bfhi(cc.z); u[d][6] = bflo(hc.w) * bflo(cc.w); u[d][7] = bfhi(hc.w) * bfhi(cc.w);
                } else {
#pragma unroll
                    for (int i = 0; i < 8; ++i) u[d][i] = 0.f; }
            }
            const u32x4 cb = *(const u32x4*)(zr + ZB_C + c0);
            const float cbv[8] = {bflo(cb.x), bfhi(cb.x), bflo(cb.y), bfhi(cb.y), bflo(cb.z), bfhi(cb.z), bflo(cb.w), bfhi(cb.w)};
            float o[8], ss = 0.f;
#pragma unroll
            for (int i = 0; i < 8; ++i) { o[i] = cbv[i] * (cw[c0 + i] * u[0][i] + cw[512 + c0 + i] * u[1][i] + cw[1024 + c0 + i] * u[2][i]); ss += o[i] * o[i]; }
            ss += __shfl_xor(ss, 1); ss += __shfl_xor(ss, 2); ss += __shfl_xor(ss, 4); ss += __shfl_xor(ss, 8);
            const float rstd = __builtin_amdgcn_rsqf(ss * (1.f / HD) + EPS);
            u32x4 w; w.x = pk2(o[0] * rstd * gcv[c0 + 0], o[1] * rstd * gcv[c0 + 1]); w.y = pk2(o[2] * rstd * gcv[c0 + 2], o[3] * rstd * gcv[c0 + 3]);
            w.z = pk2(o[4] * rstd * gcv[c0 + 4], o[5] * rstd * gcv[c0 + 5]); w.w = pk2(o[6] * rstd * gcv[c0 + 6], o[7] * rstd * gcv[c0 + 7]);
            *(u32x4*)(y + (size_t)m * DM + 1536 + c0) = w; }
    }
}

__device__ __forceinline__ void phase_mix_naive(Frame& F, int l) {
    PHASE_BEGIN();
    const bf16_t* z = (const bf16_t*)(ws + WS_Z);
    bf16_t* y = (bf16_t*)(ws + WS_Y);
    const float* pref = (const float*)(ws + WS_PREF);
    LAS float* qs = (LAS float*)F.lds; LAS float* ks = qs + 64 * 132; LAS float* vs = ks + 64 * 132; LAS float* ps = vs + 64 * 128;
    LAS float* rowA = ps + 64 * 68; LAS float* rowB = rowA + 64; LAS float* colA = rowB + 64;
    const int lr = tid >> 3, ldc = (tid & 7) * 16;
    const int rg = tid >> 4, cg = tid & 15;
    const int rg2 = tid >> 5, eg = tid & 31;
    const float kscale = 0.08838834764831845f;
    for (int it = F.vcu; it < 3 * 16 * 64; it += F.G) {
        const int tb = 63 - it / 48, rem = it % 48, mx = rem >> 4, bh = rem & 15, b = bh >> 2, h = bh & 3, t0 = tb * 64;
        const int qcol = (mx == 0 ? ZQ_R : (mx == 1 ? ZQ_F : ZQ_M)) + h * HD, kcol = (mx == 0 ? ZK_R : (mx == 1 ? ZK_F : ZK_M)) + h * HD, vcol = (mx == 0 ? ZV_R : (mx == 1 ? ZV_F : ZV_M)) + h * HD;
        const float lg2g = __builtin_log2f(1.0f - __builtin_amdgcn_exp2f(-5.0f - (float)h));
        __syncthreads();
        { const bf16_t* src = z + (size_t)(b * SEQ + t0 + lr) * NZ + qcol + ldc; const u32x4 a = *(const u32x4*)src, c = *(const u32x4*)(src + 8);
            LAS f32x4* d = (LAS f32x4*)(qs + lr * 132 + ldc);
            d[0] = (f32x4){bflo(a.x), bfhi(a.x), bflo(a.y), bfhi(a.y)}; d[1] = (f32x4){bflo(a.z), bfhi(a.z), bflo(a.w), bfhi(a.w)};
            d[2] = (f32x4){bflo(c.x), bfhi(c.x), bflo(c.y), bfhi(c.y)}; d[3] = (f32x4){bflo(c.z), bfhi(c.z), bflo(c.w), bfhi(c.w)}; }
        if (tid < 64) { const int t = t0 + tid;
            rowA[tid] = mx == 1 ? pref[(size_t)(0 * 16 + bh) * SEQ + t] : (mx == 2 ? pref[(size_t)(3 * 16 + bh) * SEQ + t] : 0.f);
            rowB[tid] = mx == 2 ? pref[(size_t)(1 * 16 + bh) * SEQ + t] : 0.f; }
        f32x4 acc[4]; float rsum[4];
#pragma unroll
        for (int a = 0; a < 4; ++a) { acc[a] = (f32x4){0.f, 0.f, 0.f, 0.f}; rsum[a] = 0.f; }
        for (int kt = 0; kt <= tb; ++kt) {
            const int j0 = kt * 64;
            __syncthreads();
            { const bf16_t* src = z + (size_t)(b * SEQ + j0 + lr) * NZ + kcol + ldc; const u32x4 a = *(const u32x4*)src, c = *(const u32x4*)(src + 8);
                LAS f32x4* d = (LAS f32x4*)(ks + lr * 132 + ldc);
                d[0] = (f32x4){bflo(a.x), bfhi(a.x), bflo(a.y), bfhi(a.y)}; d[1] = (f32x4){bflo(a.z), bfhi(a.z), bflo(a.w), bfhi(a.w)};
                d[2] = (f32x4){bflo(c.x), bfhi(c.x), bflo(c.y), bfhi(c.y)}; d[3] = (f32x4){bflo(c.z), bfhi(c.z), bflo(c.w), bfhi(c.w)}; }
            { const bf16_t* src = z + (size_t)(b * SEQ + j0 + lr) * NZ + vcol + ldc; const u32x4 a = *(const u32x4*)src, c = *(const u32x4*)(src + 8);
                LAS f32x4* d = (LAS f32x4*)(vs + lr * 128 + ldc);
                d[0] = (f32x4){bflo(a.x), bfhi(a.x), bflo(a.y), bfhi(a.y)}; d[1] = (f32x4){bflo(a.z), bfhi(a.z), bflo(a.w), bfhi(a.w)};
                d[2] = (f32x4){bflo(c.x), bfhi(c.x), bflo(c.y), bfhi(c.y)}; d[3] = (f32x4){bflo(c.z), bfhi(c.z), bflo(c.w), bfhi(c.w)}; }
            if (tid < 64) colA[tid] = mx == 1 ? pref[(size_t)(0 * 16 + bh) * SEQ + j0 + tid] : (mx == 2 ? pref[(size_t)(2 * 16 + bh) * SEQ + j0 + tid] : 0.f);
            __syncthreads();
            float dot[2][4];
#pragma unroll
            for (int a = 0; a < 2; ++a)
#pragma unroll
                for (int i = 0; i < 4; ++i) dot[a][i] = 0.f;
#pragma unroll 4
            for (int d4 = 0; d4 < 32; ++d4) {
                const f32x4 qa = *(const LAS f32x4*)(qs + (2 * rg) * 132 + 4 * d4), qb = *(const LAS f32x4*)(qs + (2 * rg + 1) * 132 + 4 * d4);
#pragma unroll
                for (int i = 0; i < 4; ++i) { const f32x4 kk = *(const LAS f32x4*)(ks + (4 * cg + i) * 132 + 4 * d4);
                    dot[0][i] += (qa.x * kk.x + qa.y * kk.y) + (qa.z * kk.z + qa.w * kk.w); dot[1][i] += (qb.x * kk.x + qb.y * kk.y) + (qb.z * kk.z + qb.w * kk.w); }
            }
#pragma unroll
            for (int a = 0; a < 2; ++a) { const int r = 2 * rg + a, t = t0 + r; const float ra = rowA[r];
                f32x4 pv;
#pragma unroll
                for (int i = 0; i < 4; ++i) { const int j = 4 * cg + i, jg = j0 + j; float p;
                    if (mx == 0) p = dot[a][i] * kscale * __builtin_amdgcn_exp2f((float)(t - jg) * lg2g);
                    else if (mx == 1) p = __expf(dot[a][i] * kscale + ra - colA[j]);
                    else p = dot[a][i] * kscale * __expf(colA[j] - ra);
                    pv[i] = jg <= t ? p : 0.f; }
                *(LAS f32x4*)(ps + r * 68 + 4 * cg) = pv; }
            __syncthreads();
#pragma unroll 4
            for (int j4 = 0; j4 < 16; ++j4) {
                f32x4 pp[4];
#pragma unroll
                for (int a = 0; a < 4; ++a) pp[a] = *(const LAS f32x4*)(ps + (4 * rg2 + a) * 68 + 4 * j4);
#pragma unroll
                for (int jj = 0; jj < 4; ++jj) { const f32x4 vv = *(const LAS f32x4*)(vs + (4 * j4 + jj) * 128 + 4 * eg);
#pragma unroll
                    for (int a = 0; a < 4; ++a) { acc[a] += pp[a][jj] * vv; rsum[a] += pp[a][jj]; } }
            }
        }
        const float* gn = P->in[I_HNG] + (size_t)l * DM + mx * 512 + h * HD + 4 * eg;
#pragma unroll
        for (int a = 0; a < 4; ++a) { const int r = 4 * rg2 + a; const size_t m = (size_t)b * SEQ + t0 + r;
            f32x4 o = acc[a];
            if (mx == 1) o = o * (1.0f / rsum[a]);
            if (mx == 2) { const float den = fmaxf(fabsf(rsum[a]), __expf(-rowB[r] - rowA[r])); o = o * (1.0f / den);
                const u32x2 g = *(const u32x2*)(z + m * NZ + ZO_M + h * HD + 4 * eg);
                o.x *= sigmoidf_(bflo(g.x)); o.y *= sigmoidf_(bfhi(g.x)); o.z *= sigmoidf_(bflo(g.y)); o.w *= sigmoidf_(bfhi(g.y)); }
            float ss = (o.x * o.x + o.y * o.y) + (o.z * o.z + o.w * o.w);
            ss += __shfl_xor(ss, 1); ss += __shfl_xor(ss, 2); ss += __shfl_xor(ss, 4); ss += __shfl_xor(ss, 8); ss += __shfl_xor(ss, 16);
            const float rstd = __builtin_amdgcn_rsqf(ss * (1.f / HD) + EPS);
            o = o * rstd; o.x *= gn[0]; o.y *= gn[1]; o.z *= gn[2]; o.w *= gn[3];
            if (mx == 0) { const u32x2 g = *(const u32x2*)(z + m * NZ + ZG_R + h * HD + 4 * eg);
                o.x *= siluf_(bflo(g.x)); o.y *= siluf_(bfhi(g.x)); o.z *= siluf_(bflo(g.y)); o.w *= siluf_(bfhi(g.y)); }
            u32x2 w; w.x = pk2(o.x, o.y); w.y = pk2(o.z, o.w);
            *(u32x2*)(y + m * DM + mx * 512 + h * HD + 4 * eg) = w; }
    }
}

__device__ __forceinline__ void phase_router(Frame& F, int l) {
    PHASE_BEGIN();
    const float* x1 = (const float*)(ws + WS_X1);
    bf16_t* hb = (bf16_t*)(ws + WS_HB);
    const float* rw = (const float*)(ws + WS_RW) + (size_t)l * 36 * DM;
    const float* g2 = P->in[I_N2G] + (size_t)l * DM;
    unsigned* gcnt = (unsigned*)(ws + WS_CTL) + CW_CNT + l * 64;
    unsigned* route = (unsigned*)(ws + WS_ROUTE);
    int* toklist = (int*)(ws + WS_TOK);
    LAS unsigned* lcnt = (LAS unsigned*)F.lds; LAS unsigned* lbase = lcnt + 32; LAS unsigned* rt = lbase + 32;
    float brg[4], bre[32];
#pragma unroll
    for (int i = 0; i < 4; ++i) brg[i] = P->in[I_BRG][l * 4 + i];
#pragma unroll
    for (int i = 0; i < 32; ++i) bre[i] = P->in[I_BRE][l * 32 + i];
    for (int bt = F.vcu; bt < T / 64; bt += F.G) {
        __syncthreads();
        if (tid < 32) lcnt[tid] = 0u;
        __syncthreads();
#pragma unroll 1
        for (int rr = 0; rr < 8; ++rr) {
            const int rl = wave * 8 + rr, m = bt * 64 + rl;
            const f32x4* xr = (const f32x4*)(x1 + (size_t)m * DM) + lane;
            f32x4 v[8]; float ss = 0.f;
#pragma unroll
            for (int j = 0; j < 8; ++j) { v[j] = xr[64 * j]; ss += (v[j].x * v[j].x + v[j].y * v[j].y) + (v[j].z * v[j].z + v[j].w * v[j].w); }
            const float rstd = __builtin_amdgcn_rsqf(wave_sum(ss) * (1.f / DM) + EPS);
            u32x2* o8 = (u32x2*)(hb + (size_t)m * DM) + lane;
#pragma unroll
            for (int j = 0; j < 8; ++j) { const f32x4 g = ((const f32x4*)g2)[64 * j + lane]; v[j] = v[j] * rstd * g;
                u32x2 o; o.x = pk2(v[j].x, v[j].y); o.y = pk2(v[j].z, v[j].w); o8[64 * j] = o; }
            float L[36];
            const float* rwl = rw; asm volatile("" : "+s"(rwl));
#pragma unroll
            for (int c = 0; c < 36; ++c) { const f32x4* wc = (const f32x4*)(rwl + (size_t)c * DM) + lane; float a = 0.f;
#pragma unroll
                for (int j = 0; j < 8; ++j) { const f32x4 w = wc[64 * j]; a += (v[j].x * w.x + v[j].y * w.y) + (v[j].z * w.z + v[j].w * w.w); }
                L[c] = wave_sum(a); if (c & 1) asm volatile("" ::: "memory"); }
            float gl[4]; float gmax = -INFINITY; int gsel = 0;
#pragma unroll
            for (int i = 0; i < 4; ++i) { gl[i] = L[i] + brg[i]; if (gl[i] > gmax) { gmax = gl[i]; gsel = i; } }
            float gsum = 0.f;
#pragma unroll
            for (int i = 0; i < 4; ++i) gsum += __expf(gl[i] - gmax);
            const float gp = 1.0f / gsum;
            float el[8];
#pragma unroll
            for (int j = 0; j < 8; ++j) { const float e0 = L[4 + j] + bre[j], e1 = L[12 + j] + bre[8 + j], e2 = L[20 + j] + bre[16 + j], e3 = L[28 + j] + bre[24 + j];
                el[j] = gsel == 0 ? e0 : (gsel == 1 ? e1 : (gsel == 2 ? e2 : e3)); }
            float m0 = -INFINITY; int i0 = 0;
#pragma unroll
            for (int j = 0; j < 8; ++j) if (el[j] > m0) { m0 = el[j]; i0 = j; }
            float m1 = -INFINITY; int i1 = 0;
#pragma unroll
            for (int j = 0; j < 8; ++j) if (j != i0 && el[j] > m1) { m1 = el[j]; i1 = j; }
            const float r = __expf(m1 - m0), w0 = gp / (1.0f + r), w1 = gp * r / (1.0f + r);
            if (lane == 0) { const unsigned e0 = (unsigned)(gsel * 8 + i0), e1 = (unsigned)(gsel * 8 + i1);
                const unsigned p0 = atomicAdd((unsigned*)(lcnt + e0), 1u), p1 = atomicAdd((unsigned*)(lcnt + e1), 1u);
                LAS unsigned* q = rt + rl * 6; q[0] = e0; q[1] = p0; q[2] = e1; q[3] = p1; q[4] = __builtin_bit_cast(unsigned, w0); q[5] = __builtin_bit_cast(unsigned, w1); }
        }
        __syncthreads();
        if (tid < 32) lbase[tid] = __hip_atomic_fetch_add(gcnt + tid, lcnt[tid], __ATOMIC_RELAXED, __HIP_MEMORY_SCOPE_AGENT);
        __syncthreads();
        if (tid < 64) { const int m = bt * 64 + tid; const LAS unsigned* q = rt + tid * 6;
            const unsigned e0 = q[0], p0 = lbase[e0] + q[1], e1 = q[2], p1 = lbase[e1] + q[3];
            toklist[(size_t)e0 * TOKCAP + p0] = m; toklist[(size_t)e1 * TOKCAP + p1] = m;
            u32x4 a; a.x = e0; a.y = p0; a.z = e1; a.w = p1; *(u32x4*)(route + (size_t)m * 8) = a;
            u32x2 b; b.x = q[4]; b.y = q[5]; *(u32x2*)(route + (size_t)m * 8 + 4) = b; }
    }
}

constexpr int NPH = 2 + 8 * DEPTH;
__global__ void __launch_bounds__(NWAVES * 64, 2) hybrid_fwd(Params p) {
    extern __shared__ __attribute__((aligned(16))) unsigned char lds_raw[];
    Frame F;
    F.lds = (LAS unsigned char*)lds_raw;
    F.G = gridDim.x; { const int bx = blockIdx.x; F.vcu = (F.G % 8 == 0) ? (bx % 8) * (F.G / 8) + bx / 8 : bx; }
    for (int u = threadIdx.x; u < (LDS_BYTES - LDSCTL_OFF) / 4; u += NWAVES * 64) ((LAS unsigned*)(F.lds + LDSCTL_OFF))[u] = 0u;
    __syncthreads();
    const int lo = p.ph_lo, hi = p.ph_hi;
    XcdBarrier bar; bar.bar = (unsigned*)(p.ws + WS_CTL) + CW_BAR; bar.x = 0; bar.st = nullptr;
    if (hi - lo > 1) bar = xcd_barrier_post((unsigned*)(p.ws + WS_CTL) + CW_BAR, (volatile LAS unsigned*)(F.lds + LDSCTL_OFF + 32));
#define IN(k) (lo <= (k) && (k) < hi)
#define SEAM(k) do { if (IN(k) && IN((k) + 1)) xcd_barrier(bar); } while (0)

    if (IN(0)) {
#ifndef DIS_W
        phase_w(F);
#endif
    }
    SEAM(0);
    for (int l = 0; l < DEPTH; ++l) {
        const int pb = 1 + 8 * l;
        if (IN(pb + 0)) {
#ifndef DIS_N1
            const KArgs P = kargs();
            if (l == 0) phase_norm1<0>(F, l, P->in[I_X], nullptr); else phase_norm1<1>(F, l, (const float*)(P->ws + WS_X1), P->out);
#endif
        }
        SEAM(pb + 0);
        if (IN(pb + 1)) {
#ifndef DIS_G1
            const KArgs P = kargs(); unsigned char* const ws = P->ws;
            pg8::SchedStatic S; S.o.init(T, NZ, F.G, (int)blockIdx.x); S.Bt = (const char*)(ws + WS_WIN + l * SZ_WIN); S.tstepB = (size_t)256 * DM * 2;
            pg8::EpiBf16 E{(bf16_t*)(ws + WS_Z), NZ};
            pg8::gemm_phase(F.lds, (const char*)(ws + WS_HB), DM, S, E);
#endif
        }
        SEAM(pb + 1);
        if (IN(pb + 2)) {
#ifndef DIS_PREP
            phase_prep(F, l);
#endif
        }
        SEAM(pb + 2);
        if (IN(pb + 3)) {
#ifndef DIS_MIX
            phase_mix_naive(F, l);
#endif
        }
        SEAM(pb + 3);
        if (IN(pb + 4)) {
#ifndef DIS_G2
            const KArgs P = kargs(); unsigned char* const ws = P->ws;
            const float* xl = l == 0 ? P->in[I_X] : (const float*)P->out;
            pg8::SchedStatic S; S.o.init(T, DM, F.G, (int)blockIdx.x); S.Bt = (const char*)(ws + WS_WOUT + l * SZ_WOUT); S.tstepB = (size_t)256 * DM * 2;
            pg8::EpiResF32 E{xl, (float*)(ws + WS_X1), DM};
            pg8::gemm_phase(F.lds, (const char*)(ws + WS_Y), DM, S, E);
#endif
        }
        SEAM(pb + 4);
        if (IN(pb + 5)) {
#ifndef DIS_ROUTER
            phase_router(F, l);
#endif
        }
        SEAM(pb + 5);
        if (IN(pb + 6)) {
#ifndef DIS_G3
            const MoeTab mt = moe_tab(F, l);
            const KArgs P = kargs(); unsigned char* const ws = P->ws;
            pg8::SchedMoe<true> S; S.G = F.G; S.c = (int)blockIdx.x; S.MT = mt.tstart[NE]; S.tstart = mt.tstart; S.cnt = mt.cnt; S.toklist = (const int*)(ws + WS_TOK);
            S.Wt = (const char*)(ws + WS_WGU + l * SZ_WGU); S.estride = (size_t)2048 * DM * 2; S.tstepB = (size_t)256 * DM * 2;
            pg8::EpiGateUp E{(bf16_t*)(ws + WS_HH)};
            pg8::gemm_phase(F.lds, (const char*)(ws + WS_HB), DM, S, E);
#endif
        }
        SEAM(pb + 6);
        if (IN(pb + 7)) {
#ifndef DIS_G4
            const MoeTab mt = moe_tab(F, l);
            const KArgs P = kargs(); unsigned char* const ws = P->ws;
            pg8::SchedMoe<false> S; S.G = F.G; S.c = (int)blockIdx.x; S.MT = mt.tstart[NE]; S.tstart = mt.tstart; S.cnt = mt.cnt; S.toklist = nullptr;
            S.Wt = (const char*)(ws + WS_WD + l * SZ_WD); S.estride = (size_t)DM * DFF * 2; S.tstepB = (size_t)256 * DFF * 2;
            pg8::EpiBf16 E{(bf16_t*)(ws + WS_Z), DM};
            pg8::gemm_phase(F.lds, (const char*)(ws + WS_HH), DFF, S, E);
#endif
        }
        SEAM(pb + 7);
    }
    if (IN(NPH - 1)) { const KArgs P = kargs(); phase_norm1<2>(F, DEPTH, (const float*)(P->ws + WS_X1), P->out); }
#undef IN
#undef SEAM
}

extern "C" void kernel_launch(void* const* d_in, const int* in_sizes, int n_in, void* d_out, int out_size, void* d_ws, size_t ws_size, hipStream_t stream) {
    static int grid = 0;
    if (grid == 0) {
        if (n_in != 20 || out_size != T * DM || ws_size < WS_END) { fprintf(stderr, "kernel_launch: unexpected shapes (n_in %d out %d ws %zu need %zu)\n", n_in, out_size, ws_size, (size_t)WS_END); grid = -1; return; }
        int dev = 0, cus = 0, per_cu = 0;
        if (hipGetDevice(&dev) != hipSuccess || hipDeviceGetAttribute(&cus, hipDeviceAttributeMultiprocessorCount, dev) != hipSuccess) { grid = -1; return; }
        if (hipFuncSetAttribute((const void*)hybrid_fwd, hipFuncAttributeMaxDynamicSharedMemorySize, LDS_BYTES) != hipSuccess) { fprintf(stderr, "kernel_launch: hipFuncSetAttribute failed\n"); grid = -1; return; }
        if (hipOccupancyMaxActiveBlocksPerMultiprocessor(&per_cu, (const void*)hybrid_fwd, NWAVES * 64, LDS_BYTES) != hipSuccess || per_cu < 1)
            fprintf(stderr, "kernel_launch: note: occupancy query reports %d workgroups per CU\n", per_cu);
        (void)hipGetLastError();
        grid = cus;
    }
    if (grid < 0) return;
    if (hipMemsetAsync((char*)d_ws + WS_CTL, 0, CTL_ZERO_BYTES, stream) != hipSuccess) return;
    Params a{};
    for (int i = 0; i < 20; ++i) a.in[i] = (const float*)d_in[i];
    a.out = (float*)d_out; a.ws = (unsigned char*)d_ws;
#if MK_PER_PHASE
    for (int ph = 0; ph < NPH; ++ph) { a.ph_lo = ph; a.ph_hi = ph + 1; hipLaunchKernelGGL(hybrid_fwd, dim3(grid), dim3(NWAVES * 64), LDS_BYTES, stream, a); }
#else
    a.ph_lo = 0; a.ph_hi = NPH;
    hipLaunchKernelGGL(hybrid_fwd, dim3(grid), dim3(NWAVES * 64), LDS_BYTES, stream, a);
#endif
    const hipError_t le = hipPeekAtLastError();
    if (le != hipSuccess) fprintf(stderr, "kernel_launch: launch failed: %s\n", hipGetErrorName(le));
}
```

```cpp
#include <hip/hip_runtime.h>
#include <cstdio>
#include <cstdint>

#ifndef MK_PER_PHASE
#define MK_PER_PHASE 0
#endif

#define GAS __attribute__((address_space(1)))
#define LAS __attribute__((address_space(3)))
typedef unsigned short bf16_t;
typedef short bf16x8 __attribute__((ext_vector_type(8)));
typedef float f32x4 __attribute__((ext_vector_type(4)));
typedef float f32x2 __attribute__((ext_vector_type(2)));
typedef unsigned u32x4 __attribute__((ext_vector_type(4)));
typedef unsigned u32x2 __attribute__((ext_vector_type(2)));
#define LDS_WAIT() asm volatile("s_waitcnt lgkmcnt(0)" ::: "memory")
#define VM_WAIT() asm volatile("s_waitcnt vmcnt(0)" ::: "memory")

constexpr int DM = 2048, NBATCH = 4, SEQ = 4096, T = NBATCH * SEQ, DEPTH = 2;
constexpr int HD = 128, NH = 4, NIN = 7180, NZ = 7168;
constexpr int NE = 32, DFF = 1024, TOKCAP = T;
constexpr float EPS = 1e-6f;
constexpr int ZQ_R = 0, ZK_R = 512, ZV_R = 1024, ZG_R = 1536, ZQ_F = 2048, ZK_F = 2560, ZV_F = 3072;
constexpr int ZQ_M = 3584, ZK_M = 4096, ZV_M = 4608, ZO_M = 5120, ZH_C = 5632, ZB_C = 6144, ZC_C = 6656;
constexpr int MAXMT = T * 2 / 256 + NE;

constexpr size_t MiB = 1u << 20;
constexpr size_t WS_CTL = 0, CTL_ZERO_BYTES = 1 * MiB;
constexpr size_t SZ_WIN = (size_t)NZ * DM * 2, SZ_WOUT = (size_t)DM * DM * 2, SZ_WGU = (size_t)NE * 2048 * DM * 2, SZ_WD = (size_t)NE * DM * DFF * 2;
constexpr size_t WS_WIN = 1 * MiB;
constexpr size_t WS_WOUT = WS_WIN + DEPTH * SZ_WIN;
constexpr size_t WS_WGU = WS_WOUT + DEPTH * SZ_WOUT;
constexpr size_t WS_WD = WS_WGU + DEPTH * SZ_WGU;
constexpr size_t WS_GW = WS_WD + DEPTH * SZ_WD;
constexpr size_t WS_RW = WS_GW + DEPTH * 12 * DM * 4;
constexpr size_t WS_HB = WS_RW + DEPTH * 36 * DM * 4;
constexpr size_t WS_Z = WS_HB + (size_t)T * DM * 2;
constexpr size_t WS_GATES = WS_Z + (size_t)T * NZ * 2;
constexpr size_t WS_PREF = WS_GATES + (size_t)T * 12 * 4;
constexpr size_t WS_Y = WS_PREF + 4 * 16 * SEQ * 4;
constexpr size_t WS_X1 = WS_Y + (size_t)T * DM * 2;
constexpr size_t WS_HH = WS_X1 + (size_t)T * DM * 4;
constexpr size_t WS_ROUTE = WS_HH + (size_t)MAXMT * 256 * DFF * 2;
constexpr size_t WS_TOK = WS_ROUTE + (size_t)T * 32;
constexpr size_t WS_STATE = WS_TOK + (size_t)NE * TOKCAP * 4;
constexpr size_t WS_END = WS_STATE + 80 * MiB;
static_assert((size_t)MAXMT * 256 * DM * 2 <= (size_t)T * NZ * 2, "ys overlays z");
constexpr int CW_BAR = 4096;
constexpr int CW_CNT = 16384;

constexpr int RING_BYTES = 131072;
constexpr int LDSCTL_OFF = RING_BYTES;
constexpr int LDS_BYTES = 147456;
constexpr int NWAVES = 8;

__device__ __forceinline__ unsigned f2bf(float f) { unsigned u = __builtin_bit_cast(unsigned, f); return (u + 0x7fffu + ((u >> 16) & 1u)) >> 16; }
__device__ __forceinline__ unsigned pk2(float lo, float hi) { return f2bf(lo) | (f2bf(hi) << 16); }
__device__ __forceinline__ float bflo(unsigned w) { return __builtin_bit_cast(float, w << 16); }
__device__ __forceinline__ float bfhi(unsigned w) { return __builtin_bit_cast(float, w & 0xffff0000u); }
__device__ __forceinline__ float bf2f(bf16_t b) { return __builtin_bit_cast(float, (unsigned)b << 16); }
__device__ __forceinline__ float wave_sum(float v) {
#pragma unroll
    for (int o = 1; o < 64; o <<= 1) v += __shfl_xor(v, o);
    return v;
}
__device__ __forceinline__ float fast_exp(float x) { return __builtin_amdgcn_exp2f(x * 1.4426950408889634f); }
__device__ __forceinline__ float sigmoidf_(float x) { return __builtin_amdgcn_rcpf(1.0f + fast_exp(-x)); }
__device__ __forceinline__ float siluf_(float x) { return x * sigmoidf_(x); }
__device__ __forceinline__ float log_sigmoidf_(float x) { return fminf(x, 0.0f) - log1pf(__expf(-fabsf(x))); }

namespace pg8 {
constexpr int BM = 256, BK = 64, HALF = 128, HTB = HALF * BK * 2, STAGE_BYTES = 8 * HTB, NXCD = 8, WGM = 8;
__host__ __device__ __forceinline__ int lds_byte(int r, int c) { const int st = (r >> 4) * 2 + (c >> 5), rr = r & 15, cc = c & 31, ob = rr * 64 + cc * 2; return st * 1024 + (ob ^ (((ob >> 9) & 1) << 5)); }
__host__ __device__ __forceinline__ void stage_rc(int b, int& R, int& C) { const int st = b / 1024, sb = b % 1024, swz = sb ^ (((sb >> 9) & 1) << 5); R = (st >> 1) * 16 + swz / 64; C = (st & 1) * 32 + (swz % 64) / 2; }
__host__ __device__ __forceinline__ int perm32(int rho) { const int n = rho >> 4, i = rho & 15; return 8 * (i >> 2) + 4 * n + (i & 3); }

struct Unit { int pm, pn, e; };

struct StaticOrder {
    int nM, nN, nwg, G, c;
    __host__ __device__ void init(int M, int N, int G_, int c_) { nM = M / BM; nN = N / BM; nwg = nM * nN; G = G_; c = c_; }
    __host__ __device__ bool next(int i, Unit& u) const {
        const long L = (long)i * G + c; if (L >= nwg) return false;
        int wgid = (int)L; { const int q = nwg / NXCD, r = nwg % NXCD, xcd = wgid % NXCD, off = wgid / NXCD; wgid = (xcd < r ? xcd * (q + 1) : r * (q + 1) + (xcd - r) * q) + off; }
        const int nig = WGM * nN, gid = wgid / nig, fm = gid * WGM, gsz = (nM - fm) < WGM ? (nM - fm) : WGM;
        u.pm = fm + ((wgid % nig) % gsz); u.pn = (wgid % nig) / gsz; u.e = 0; return true;
    }
};
struct SchedStatic {
    StaticOrder o; const char* Bt; size_t tstepB;
    __device__ __forceinline__ bool next(int i, Unit& u) const { return o.next(i, u); }
    __device__ __forceinline__ int arow(const Unit& u, int r) const { return u.pm * BM + r; }
    __device__ __forceinline__ const char* bptr(const Unit& u) const { return Bt + (size_t)u.pn * tstepB; }
};
template <bool GATHER> struct SchedMoe {
    int G, c, MT; const LAS int* tstart; const LAS int* cnt; const int* toklist; const char* Wt; size_t estride, tstepB;
    __device__ __forceinline__ bool next(int i, Unit& u) const {
        const int L = i * G + c; if (L >= MT * 8) return false;
        u.pm = L >> 3; u.pn = L & 7; int e = 0;
        for (; e < NE - 1; ++e) if (u.pm < tstart[e + 1]) break;
        u.e = e; return true;
    }
    __device__ __forceinline__ int arow(const Unit& u, int r) const {
        if (!GATHER) return u.pm * BM + r;
        const int idx = (u.pm - tstart[u.e]) * BM + r;
        return idx < cnt[u.e] ? toklist[(size_t)u.e * TOKCAP + idx] : 0;
    }
    __device__ __forceinline__ const char* bptr(const Unit& u) const { return Wt + (size_t)u.e * estride + (size_t)u.pn * tstepB; }
};

struct EpiBf16 {
    static constexpr bool PERM = true;
    bf16_t* O; int ldc;
    __device__ __forceinline__ void operator()(const f32x4 (&acc)[2][2][4][2], const Unit& u, int wr, int wc, int fr, int fq) const {
        const int row0 = u.pm * BM + wr * 64 + fr, col0 = u.pn * BM + wc * 32 + 8 * fq;
#pragma unroll
        for (int ai = 0; ai < 2; ++ai)
#pragma unroll
            for (int m = 0; m < 4; ++m) { bf16_t* rowp = O + (size_t)(row0 + ai * HALF + m * 16) * ldc + col0;
#pragma unroll
                for (int bj = 0; bj < 2; ++bj) { const f32x4 v0 = acc[ai][bj][m][0], v1 = acc[ai][bj][m][1];
                    u32x4 w; w.x = pk2(v0[0], v0[1]); w.y = pk2(v0[2], v0[3]); w.z = pk2(v1[0], v1[1]); w.w = pk2(v1[2], v1[3]);
                    *(u32x4*)(rowp + bj * HALF) = w; } }
    }
};
struct EpiResF32 {
    static constexpr bool PERM = false;
    const float* R; float* C; int ldc;
    __device__ __forceinline__ void operator()(const f32x4 (&acc)[2][2][4][2], const Unit& u, int wr, int wc, int fr, int fq) const {
        const int row0 = u.pm * BM + wr * 64 + fr, col0 = u.pn * BM + wc * 32 + 4 * fq;
#pragma unroll
        for (int ai = 0; ai < 2; ++ai)
#pragma unroll
            for (int m = 0; m < 4; ++m) { const size_t off = (size_t)(row0 + ai * HALF + m * 16) * ldc + col0;
#pragma unroll
                for (int bj = 0; bj < 2; ++bj)
#pragma unroll
                    for (int n = 0; n < 2; ++n) { const f32x4 r = *(const f32x4*)(R + off + bj * HALF + n * 16); *(f32x4*)(C + off + bj * HALF + n * 16) = r + acc[ai][bj][m][n]; }
                asm volatile("" ::: "memory"); }
    }
};
struct EpiGateUp {
    static constexpr bool PERM = true;
    bf16_t* H;
    __device__ __forceinline__ void operator()(const f32x4 (&acc)[2][2][4][2], const Unit& u, int wr, int wc, int fr, int fq) const {
        const int row0 = u.pm * BM + wr * 64 + fr, col0 = u.pn * HALF + wc * 32 + 8 * fq;
#pragma unroll
        for (int ai = 0; ai < 2; ++ai)
#pragma unroll
            for (int m = 0; m < 4; ++m) { bf16_t* rowp = H + (size_t)(row0 + ai * HALF + m * 16) * DFF + col0;
                float o[8];
#pragma unroll
                for (int n = 0; n < 2; ++n)
#pragma unroll
                    for (int j = 0; j < 4; ++j) { const float g = acc[ai][0][m][n][j], up = acc[ai][1][m][n][j]; o[n * 4 + j] = siluf_(g) * up; }
                u32x4 w; w.x = pk2(o[0], o[1]); w.y = pk2(o[2], o[3]); w.z = pk2(o[4], o[5]); w.w = pk2(o[6], o[7]);
                *(u32x4*)rowp = w; }
    }
};

template <class Epi, class Sched>
__device__ __forceinline__ void gemm_phase(LAS unsigned char* lds, const char* Abase, const int K, const Sched& S, const Epi& E) {
    int tid = threadIdx.x; asm volatile("" : "+v"(tid));
    const int wid = __builtin_amdgcn_readfirstlane(tid >> 6), lane = tid & 63, wr = wid >> 2, wc = wid & 3, fr = lane & 15, fq = lane >> 4;
    const int nt = K / BK;
    int Ri[2]; unsigned Ci[2], voffB[2];
#pragma unroll
    for (int i = 0; i < 2; ++i) { int R, C; stage_rc(tid * 16 + i * 8192, R, C); const int Rb = Epi::PERM ? ((R & ~31) + perm32(R & 31)) : R;
        Ri[i] = R; Ci[i] = (unsigned)C * 2u; voffB[i] = (unsigned)(Rb * K + C) * 2u; }
    const unsigned rowB = (unsigned)K * 2u;
    const size_t kstep = (size_t)(BK * 2);
    const size_t hstep = (size_t)HALF * K * 2;
    const unsigned ldsw = (unsigned)wid * 1024u;
    const int aoff = lds_byte(wr * 64 + fr, fq * 8), boff = lds_byte(wc * 32 + fr, fq * 8);
#define PG8_SA(b, h) (((b) * 2 + (h)) * HTB)
#define PG8_SB(b, h) ((4 + (b) * 2 + (h)) * HTB)
#define PG8_STAGE(bufoff, gbase, voff) do { _Pragma("unroll") for (int _i = 0; _i < 2; ++_i) \
        __builtin_amdgcn_global_load_lds((const unsigned*)((const char*)(gbase) + (voff)[_i]), (LAS unsigned*)(lds + (bufoff) + ldsw + _i * 8192), 16, 0, 0); } while (0)
#define PG8_LDA(dst, b, h) do { _Pragma("unroll") for (int m = 0; m < 4; ++m) _Pragma("unroll") for (int k = 0; k < 2; ++k) dst[m][k] = *(const LAS bf16x8*)(lds + PG8_SA(b, h) + aoff + m * 2048 + k * 1024); } while (0)
#define PG8_LDB(dst, b, h) do { _Pragma("unroll") for (int n = 0; n < 2; ++n) _Pragma("unroll") for (int k = 0; k < 2; ++k) dst[n][k] = *(const LAS bf16x8*)(lds + PG8_SB(b, h) + boff + n * 2048 + k * 1024); } while (0)
#define PG8_MMA(ai, bj, At, Bt) do { __builtin_amdgcn_s_setprio(1); _Pragma("unroll") for (int m = 0; m < 4; ++m) _Pragma("unroll") for (int n = 0; n < 2; ++n) _Pragma("unroll") for (int k = 0; k < 2; ++k) \
        acc[ai][bj][m][n] = __builtin_amdgcn_mfma_f32_16x16x32_bf16(Bt[n][k], At[m][k], acc[ai][bj][m][n], 0, 0, 0); __builtin_amdgcn_s_setprio(0); } while (0)
#define PG8_WAIT_V(n) asm volatile("s_waitcnt vmcnt(" #n ")" ::: "memory")
#define PG8_WAIT_L(n) asm volatile("s_waitcnt lgkmcnt(" #n ")" ::: "memory")
#define PG8_BAR __builtin_amdgcn_s_barrier()
#define PG8_SCHED __builtin_amdgcn_sched_barrier(0)
#define PG8_AOFF(dst, u) do { _Pragma("unroll") for (int _h = 0; _h < 2; ++_h) _Pragma("unroll") for (int _i = 0; _i < 2; ++_i) \
        dst[_h][_i] = (unsigned)S.arow(u, _h * HALF + Ri[_i]) * rowB + Ci[_i]; } while (0)
    Unit cur, nxt; int ui = 0;
    if (!S.next(0, cur)) return;
    f32x4 acc[2][2][4][2];
#pragma unroll
    for (int a = 0; a < 2; ++a)
#pragma unroll
        for (int b = 0; b < 2; ++b)
#pragma unroll
            for (int m = 0; m < 4; ++m)
#pragma unroll
                for (int n = 0; n < 2; ++n) acc[a][b][m][n] = (f32x4){0.f, 0.f, 0.f, 0.f};
    bf16x8 At[4][2], B0[2][2], B1[2][2];
    unsigned ac[2][2], an[2][2];
    PG8_AOFF(ac, cur);
    const char* cB = S.bptr(cur);
    PG8_STAGE(PG8_SB(0, 0), cB, voffB); PG8_STAGE(PG8_SB(0, 1), cB + hstep, voffB); PG8_STAGE(PG8_SA(0, 0), Abase, ac[0]); PG8_STAGE(PG8_SA(0, 1), Abase, ac[1]);
    if (wr == 1) PG8_BAR;
    PG8_WAIT_V(2); PG8_BAR;
    PG8_STAGE(PG8_SB(1, 0), cB + kstep, voffB); PG8_STAGE(PG8_SA(1, 0), Abase + kstep, ac[0]); PG8_STAGE(PG8_SB(1, 1), cB + hstep + kstep, voffB);
    PG8_WAIT_V(6); PG8_BAR;
    for (;;) {
        const bool has_next = S.next(ui + 1, nxt);
        const char* nB = cB;
        if (has_next) { PG8_AOFF(an, nxt); nB = S.bptr(nxt); }
        else {
#pragma unroll
            for (int h = 0; h < 2; ++h)
#pragma unroll
                for (int i = 0; i < 2; ++i) an[h][i] = ac[h][i]; }
        for (int t = 0; t < nt; t += 2) {
            const bool last = (t == nt - 2);
            const char* a1 = Abase + (size_t)(t + 1) * kstep;
            const char* a2 = last ? Abase : Abase + (size_t)(t + 2) * kstep; const char* b2 = last ? nB : cB + (size_t)(t + 2) * kstep;
            const char* a3 = a2 + kstep; const char* b3 = b2 + kstep;
            unsigned a2o[2][2];
#pragma unroll
            for (int h = 0; h < 2; ++h)
#pragma unroll
                for (int i = 0; i < 2; ++i) a2o[h][i] = last ? an[h][i] : ac[h][i];
            PG8_LDB(B0, 0, 0); PG8_LDB(B1, 0, 1); PG8_SCHED; PG8_LDA(At, 0, 0); PG8_STAGE(PG8_SA(1, 1), a1, ac[1]);
            PG8_WAIT_V(8); PG8_WAIT_L(0); PG8_BAR; PG8_MMA(0, 0, At, B0); PG8_MMA(0, 1, At, B1); PG8_BAR; PG8_SCHED;
            PG8_LDA(At, 0, 1); PG8_STAGE(PG8_SB(0, 0), b2, voffB); PG8_STAGE(PG8_SB(0, 1), b2 + hstep, voffB); PG8_STAGE(PG8_SA(0, 0), a2, a2o[0]);
            PG8_WAIT_V(8); PG8_WAIT_L(0); PG8_BAR; PG8_MMA(1, 0, At, B0); PG8_MMA(1, 1, At, B1); PG8_BAR; PG8_SCHED;
            PG8_LDB(B0, 1, 0); PG8_LDB(B1, 1, 1); PG8_SCHED; PG8_LDA(At, 1, 0); PG8_STAGE(PG8_SA(0, 1), a2, a2o[1]);
            PG8_WAIT_V(8); PG8_WAIT_L(0); PG8_BAR; PG8_MMA(0, 0, At, B0); PG8_MMA(0, 1, At, B1); PG8_BAR; PG8_SCHED;
            PG8_LDA(At, 1, 1); PG8_STAGE(PG8_SB(1, 0), b3, voffB); PG8_STAGE(PG8_SB(1, 1), b3 + hstep, voffB); PG8_STAGE(PG8_SA(1, 0), a3, a2o[0]);
            PG8_WAIT_V(8); PG8_WAIT_L(0); PG8_BAR; PG8_MMA(1, 0, At, B0); PG8_MMA(1, 1, At, B1); PG8_BAR; PG8_SCHED;
        }
        if (wr == 0) PG8_BAR;
        E(acc, cur, wr, wc, fr, fq);
        if (!has_next) break;
#pragma unroll
        for (int a = 0; a < 2; ++a)
#pragma unroll
            for (int b = 0; b < 2; ++b)
#pragma unroll
                for (int m = 0; m < 4; ++m)
#pragma unroll
                    for (int n = 0; n < 2; ++n) acc[a][b][m][n] = (f32x4){0.f, 0.f, 0.f, 0.f};
        cur = nxt; cB = nB; ++ui;
#pragma unroll
        for (int h = 0; h < 2; ++h)
#pragma unroll
            for (int i = 0; i < 2; ++i) ac[h][i] = an[h][i];
        if (wr == 1) PG8_BAR;
    }
    PG8_WAIT_V(0);
    PG8_BAR;
#undef PG8_SA
#undef PG8_SB
#undef PG8_STAGE
#undef PG8_LDA
#undef PG8_LDB
#undef PG8_MMA
#undef PG8_WAIT_V
#undef PG8_WAIT_L
#undef PG8_BAR
#undef PG8_SCHED
#undef PG8_AOFF
}
}

#define XB_TMO      128
#define XB_XCNT(j)  (256  + 64 * (j))
#define XB_XSUB(j)  (1280 + 64 * (j))
#define XB_XGEN(j)  (2304 + 64 * (j))
#define XB_TOP      3328
#define XB_TOPGEN   3392
#define XCD_BAR_WORDS 3456
#define XB_SPIN_CAP (1u << 18)
__device__ __forceinline__ unsigned xb_ld(unsigned* p)              { return __hip_atomic_load(p, __ATOMIC_RELAXED, __HIP_MEMORY_SCOPE_AGENT); }
__device__ __forceinline__ unsigned xb_add(unsigned* p, unsigned v) { return __hip_atomic_fetch_add(p, v, __ATOMIC_RELAXED, __HIP_MEMORY_SCOPE_AGENT); }
__device__ __forceinline__ unsigned xb_xcc_id() { return (unsigned)__builtin_amdgcn_s_getreg((3 << 11) | 20) & 0xFu; }
#define XB_SPIN(cond, bar) do { unsigned _sp = 0; while (cond) { __builtin_amdgcn_s_sleep(1); \
    if ((++_sp & 255u) == 0u) { if (xb_ld(&(bar)[XB_TMO])) break; if (_sp > XB_SPIN_CAP) { atomicAdd(&(bar)[XB_TMO], 1u); break; } } } } while (0)
struct XcdBarrier { unsigned* bar; unsigned x; volatile LAS unsigned* st; };
__device__ __forceinline__ XcdBarrier xcd_barrier_post(unsigned* bar, volatile LAS unsigned* st) {
    XcdBarrier b; b.bar = bar; b.x = xb_xcc_id(); b.st = st;
    if (threadIdx.x == 0) (void)xb_add(&bar[XB_XCNT(b.x)], 1u);
    return b;
}
__device__ __forceinline__ void xcd_barrier_complete(unsigned* bar, unsigned x, unsigned& nloc, unsigned& nx) {
    const unsigned G = gridDim.x * gridDim.y * gridDim.z;
    unsigned sum, cnt, mine, sp = 0u;
    for (;;) {
        sum = 0u; cnt = 0u; mine = 0u;
#pragma unroll
        for (unsigned j = 0; j < 16; ++j) { const unsigned c = xb_ld(&bar[XB_XCNT(j)]); sum += c; cnt += (c > 0u) ? 1u : 0u; mine = (j == x) ? c : mine; }
        if (sum == G) break;
        __builtin_amdgcn_s_sleep(1);
        if ((++sp & 255u) == 0u) { if (xb_ld(&bar[XB_TMO])) break; if (sp > XB_SPIN_CAP) { atomicAdd(&bar[XB_TMO], 1u); break; } }
    }
    nloc = mine > 0u ? mine : 1u; nx = cnt > 0u ? cnt : 1u;
}
__device__ __forceinline__ void xcd_barrier(const XcdBarrier& b) {
    asm volatile("s_waitcnt vmcnt(0)" ::: "memory");
    __syncthreads();
    if (threadIdx.x == 0) {
        unsigned* bar = b.bar;
        __builtin_amdgcn_s_waitcnt(0);
        unsigned nloc = b.st[0], nx = b.st[1];
        if (nloc == 0u) { xcd_barrier_complete(bar, b.x, nloc, nx); b.st[0] = nloc; b.st[1] = nx; }
        const unsigned old = xb_add(&bar[XB_XSUB(b.x)], 1u);
        const unsigned gen = old / nloc;
        if (old + 1u == (gen + 1u) * nloc) {
            __builtin_amdgcn_fence(__ATOMIC_RELEASE, "agent");
            asm volatile("s_waitcnt vmcnt(0)" ::: "memory");
            const unsigned og = xb_add(&bar[XB_TOP], 1u);
            const unsigned tg = og / nx;
            if (og + 1u == (tg + 1u) * nx) xb_add(&bar[XB_TOPGEN], 1u);
            else XB_SPIN(xb_ld(&bar[XB_TOPGEN]) == tg, bar);
            __builtin_amdgcn_fence(__ATOMIC_ACQUIRE, "agent");
            xb_add(&bar[XB_XGEN(b.x)], 1u);
            asm volatile("s_waitcnt vmcnt(0)" ::: "memory");
        } else {
            XB_SPIN(xb_ld(&bar[XB_XGEN(b.x)]) == gen, bar);
            __builtin_amdgcn_fence(__ATOMIC_ACQUIRE, "agent");
            asm volatile("s_waitcnt vmcnt(0)" ::: "memory");
        }
    }
    __syncthreads();
}

struct Params { const float* in[20]; float* out; unsigned char* ws; int ph_lo, ph_hi; };
struct Frame { LAS unsigned char* lds; int vcu, G; };
typedef const __attribute__((address_space(4))) Params* KArgs;
__device__ __forceinline__ KArgs kargs() { KArgs q = (KArgs)__builtin_amdgcn_kernarg_segment_ptr(); asm volatile("" : "+s"(q)); return q; }
#define PHASE_BEGIN() const KArgs P = kargs(); unsigned char* const ws = P->ws; int tid = threadIdx.x; asm volatile("" : "+v"(tid)); \
    const int lane = tid & 63; const int wave = __builtin_amdgcn_readfirstlane(tid >> 6); (void)lane; (void)wave; (void)ws
enum { I_X = 0, I_POS, I_N1G, I_WIN, I_FFB, I_FQN, I_FKN, I_MIB, I_MFB, I_CONVW, I_HNG, I_WOUT, I_N2G, I_WRG, I_BRG, I_WRE, I_BRE, I_WG, I_WU, I_WD };

__device__ __forceinline__ void transpose_item(const float* W, int K, int Nsrc, bf16_t* WT, int src_n0, int dst_r0, int k0, LAS float* scr, int lane) {
#pragma unroll 8
    for (int i = 0; i < 32; ++i) { const int kk = 2 * i + (lane >> 5); scr[kk * 33 + (lane & 31)] = W[(size_t)(k0 + kk) * Nsrc + src_n0 + (lane & 31)]; }
    LDS_WAIT();
    const int c = lane & 7;
#pragma unroll
    for (int j = 0; j < 4; ++j) { const int n = (lane >> 3) + 8 * j; const LAS float* s = scr + (8 * c) * 33 + n;
        u32x4 o; o.x = pk2(s[0 * 33], s[1 * 33]); o.y = pk2(s[2 * 33], s[3 * 33]); o.z = pk2(s[4 * 33], s[5 * 33]); o.w = pk2(s[6 * 33], s[7 * 33]);
        *(u32x4*)(WT + (size_t)(dst_r0 + n) * K + k0 + 8 * c) = o; }
    LDS_WAIT();
}
__device__ __forceinline__ void phase_w(Frame& F) {
    PHASE_BEGIN();
    LAS float* scr = (LAS float*)(F.lds + wave * 16384);
    const int gw = F.vcu * NWAVES + wave, NGW = F.G * NWAVES;
    constexpr int I_IN = 32 * 224, I_OUT = 32 * 64, I_EX = NE * 1024, PER_L = I_IN + I_OUT + 3 * I_EX;
    for (int it = gw; it < DEPTH * PER_L; it += NGW) {
        const int l = it / PER_L; int r = it % PER_L;
        if (r < I_IN) { const int kb = r / 224, nb = r % 224, n0 = nb * 32, src = n0 + (n0 >= 5632 ? 12 : (n0 >= 3584 ? 4 : 0));
            transpose_item(P->in[I_WIN] + (size_t)l * DM * NIN, DM, NIN, (bf16_t*)(ws + WS_WIN + l * SZ_WIN), src, n0, kb * 64, scr, lane); continue; }
        r -= I_IN;
        if (r < I_OUT) { const int kb = r / 64, nb = r % 64;
            transpose_item(P->in[I_WOUT] + (size_t)l * DM * DM, DM, DM, (bf16_t*)(ws + WS_WOUT + l * SZ_WOUT), nb * 32, nb * 32, kb * 64, scr, lane); continue; }
        r -= I_OUT;
        if (r < 2 * I_EX) { const int up = r >= I_EX; if (up) r -= I_EX;
            const int e = r >> 10, q = r & 1023, kb = q >> 5, nb = q & 31, n0 = nb * 32, dst = (n0 >> 7) * 256 + (n0 & 127) + (up ? 128 : 0);
            const float* W = P->in[up ? I_WU : I_WG] + (size_t)(l * NE + e) * DM * DFF;
            transpose_item(W, DM, DFF, (bf16_t*)(ws + WS_WGU + l * SZ_WGU) + (size_t)e * 2048 * DM, n0, dst, kb * 64, scr, lane); continue; }
        r -= 2 * I_EX;
        { const int e = r >> 10, q = r & 1023, kb = q >> 6, nb = q & 63;
            transpose_item(P->in[I_WD] + (size_t)(l * NE + e) * DFF * DM, DFF, DM, (bf16_t*)(ws + WS_WD + l * SZ_WD) + (size_t)e * DM * DFF, nb * 32, nb * 32, kb * 64, scr, lane); }
    }
    for (int idx = F.vcu * 512 + tid; idx < DEPTH * 48 * DM; idx += F.G * 512) {
        const int l = idx / (48 * DM), r = idx % (48 * DM), c = r / DM, k = r % DM;
        if (c < 12) { const int col = c < 4 ? 3584 + c : 5636 + (c - 4);
            ((float*)(ws + WS_GW))[(size_t)(l * 12 + c) * DM + k] = P->in[I_WIN][(size_t)l * DM * NIN + (size_t)k * NIN + col]; }
        else { const int cc = c - 12;
            const float v = cc < 4 ? P->in[I_WRG][((size_t)l * DM + k) * 4 + cc] : P->in[I_WRE][((size_t)l * DM + k) * 32 + (cc - 4)];
            ((float*)(ws + WS_RW))[(size_t)(l * 36 + cc) * DM + k] = v; }
    }
}

struct MoeTab { LAS int* tstart; LAS int* cnt; };
__device__ __forceinline__ MoeTab moe_tab(Frame& F, int l) {
    PHASE_BEGIN();
    MoeTab mt; mt.tstart = (LAS int*)(F.lds + LDSCTL_OFF + 1024); mt.cnt = (LAS int*)(F.lds + LDSCTL_OFF + 1024 + 256);
    const unsigned* gc = (const unsigned*)(ws + WS_CTL) + CW_CNT + l * 64;
    if (tid < NE) mt.cnt[tid] = (int)__hip_atomic_load(gc + tid, __ATOMIC_RELAXED, __HIP_MEMORY_SCOPE_AGENT);
    __syncthreads();
    if (tid == 0) { int s = 0; for (int e = 0; e < NE; ++e) { mt.tstart[e] = s; s += (mt.cnt[e] + 255) >> 8; } mt.tstart[NE] = s; }
    __syncthreads();
    return mt;
}

template <int MODE>
__device__ __forceinline__ void phase_norm1(Frame& F, int l, const float* xin, float* xout) {
    PHASE_BEGIN();
    LAS f32x4* gwl = (LAS f32x4*)F.lds;
    MoeTab mt{};
    if (MODE != 0) mt = moe_tab(F, l - 1);
    if (MODE != 2) { const f32x4* src = (const f32x4*)(ws + WS_GW + (size_t)l * 12 * DM * 4);
        for (int i = tid; i < 12 * DM / 4; i += 512) gwl[i] = src[i];
        __syncthreads(); }
    const int gw = F.vcu * NWAVES + wave, NGW = F.G * NWAVES;
    const bf16_t* ys = (const bf16_t*)(ws + WS_Z);
    const unsigned* route = (const unsigned*)(ws + WS_ROUTE);
    bf16_t* hb = (bf16_t*)(ws + WS_HB);
    float* gates = (float*)(ws + WS_GATES);
    const float* g1 = P->in[I_N1G] + (size_t)(MODE == 2 ? 0 : l) * DM;
    for (int m = gw; m < T; m += NGW) {
        const f32x4* xr = (const f32x4*)(xin + (size_t)m * DM) + lane;
        f32x4 v[8];
#pragma unroll
        for (int j = 0; j < 8; ++j) v[j] = xr[64 * j];
        if (MODE != 0) {
            const u32x4 r0 = *(const u32x4*)(route + (size_t)m * 8); const u32x2 r1 = *(const u32x2*)(route + (size_t)m * 8 + 4);
            const int s0 = mt.tstart[r0.x] * 256 + (int)r0.y, s1 = mt.tstart[r0.z] * 256 + (int)r0.w;
            const unsigned w0u = r1.x, w1u = r1.y;
            const float w0 = __builtin_bit_cast(float, w0u), w1 = __builtin_bit_cast(float, w1u);
            const u32x2* y0 = (const u32x2*)(ys + (size_t)s0 * DM) + lane; const u32x2* y1 = (const u32x2*)(ys + (size_t)s1 * DM) + lane;
#pragma unroll
            for (int j = 0; j < 8; ++j) { const u32x2 a = y0[64 * j], b = y1[64 * j];
                v[j].x += w0 * bflo(a.x) + w1 * bflo(b.x); v[j].y += w0 * bfhi(a.x) + w1 * bfhi(b.x);
                v[j].z += w0 * bflo(a.y) + w1 * bflo(b.y); v[j].w += w0 * bfhi(a.y) + w1 * bfhi(b.y); }
            f32x4* xo = (f32x4*)(xout + (size_t)m * DM) + lane;
#pragma unroll
            for (int j = 0; j < 8; ++j) xo[64 * j] = v[j];
        }
        if (MODE == 2) continue;
        float ss = 0.f;
#pragma unroll
        for (int j = 0; j < 8; ++j) ss += (v[j].x * v[j].x + v[j].y * v[j].y) + (v[j].z * v[j].z + v[j].w * v[j].w);
        const float rstd = __builtin_amdgcn_rsqf(wave_sum(ss) * (1.f / DM) + EPS);
        u32x2* o8 = (u32x2*)(hb + (size_t)m * DM) + lane;
#pragma unroll
        for (int j = 0; j < 8; ++j) { const f32x4 g = ((const f32x4*)g1)[64 * j + lane]; v[j] = v[j] * rstd * g;
            u32x2 o; o.x = pk2(v[j].x, v[j].y); o.y = pk2(v[j].z, v[j].w); o8[64 * j] = o; }
        float gs[12];
#pragma unroll
        for (int c = 0; c < 12; ++c) { float a = 0.f;
#pragma unroll
            for (int j = 0; j < 8; ++j) { const f32x4 w = gwl[c * 512 + 64 * j + lane]; a += (v[j].x * w.x + v[j].y * w.y) + (v[j].z * w.z + v[j].w * w.w); }
            gs[c] = wave_sum(a); if (c & 1) asm volatile("" ::: "memory"); }
        if (lane == 0) { f32x4* go = (f32x4*)(gates + (size_t)m * 12);
            go[0] = (f32x4){gs[0], gs[1], gs[2], gs[3]}; go[1] = (f32x4){gs[4], gs[5], gs[6], gs[7]}; go[2] = (f32x4){gs[8], gs[9], gs[10], gs[11]}; }
    }
}

__device__ __forceinline__ float block_excl_sum(int lane, int wave, float tot, LAS float* sc) {
    float inc = tot;
#pragma unroll
    for (int o = 1; o < 64; o <<= 1) { const float t = __shfl_up(inc, o); if (lane >= o) inc += t; }
    __syncthreads();
    if (lane == 63) sc[wave] = inc;
    __syncthreads();
    float base = 0.f;
    for (int w = 0; w < wave; ++w) base += sc[w];
    return base + inc - tot;
}
__device__ __forceinline__ float block_excl_max(int lane, int wave, float tot, LAS float* sc) {
    float inc = tot;
#pragma unroll
    for (int o = 1; o < 64; o <<= 1) { const float t = __shfl_up(inc, o); if (lane >= o) inc = fmaxf(inc, t); }
    __syncthreads();
    if (lane == 63) sc[wave] = inc;
    __syncthreads();
    float base = -INFINITY;
    for (int w = 0; w < wave; ++w) base = fmaxf(base, sc[w]);
    const float prev = __shfl_up(inc, 1);
    return fmaxf(base, lane == 0 ? -INFINITY : prev);
}

__device__ __forceinline__ void phase_prep(Frame& F, int l) {
    PHASE_BEGIN();
    bf16_t* z = (bf16_t*)(ws + WS_Z);
    bf16_t* y = (bf16_t*)(ws + WS_Y);
    const float* gates = (const float*)(ws + WS_GATES);
    float* pref = (float*)(ws + WS_PREF);
    for (int it = F.vcu; it < 32; it += F.G) {
        const int kind = it >> 4, bh = it & 15, b = bh >> 2, h = bh & 3;
        LAS float* sc = (LAS float*)(F.lds + 65536);
        const int s0 = tid * 8;
        float v[8], a[8];
        if (kind == 0) {
            const float fb = P->in[I_FFB][l * NH + h];
            float run = 0.f;
#pragma unroll
            for (int i = 0; i < 8; ++i) { run += log_sigmoidf_(gates[(size_t)(b * SEQ + s0 + i) * 12 + h] + fb); v[i] = run; }
            const float base = block_excl_sum(lane, wave, run, sc);
#pragma unroll
            for (int i = 0; i < 8; ++i) pref[(size_t)(0 * 16 + bh) * SEQ + s0 + i] = base + v[i];
        } else {
            const float fb = P->in[I_MFB][l * NH + h], ib = P->in[I_MIB][l * NH + h];
            float run = 0.f;
#pragma unroll
            for (int i = 0; i < 8; ++i) { run += log_sigmoidf_(gates[(size_t)(b * SEQ + s0 + i) * 12 + 8 + h] + fb); v[i] = run; }
            const float base = block_excl_sum(lane, wave, run, sc);
            float mx = -INFINITY;
#pragma unroll
            for (int i = 0; i < 8; ++i) { v[i] += base; a[i] = gates[(size_t)(b * SEQ + s0 + i) * 12 + 4 + h] + ib - v[i]; mx = fmaxf(mx, a[i]); }
            float pm = fmaxf(block_excl_max(lane, wave, mx, sc + 16), 0.f);
#pragma unroll
            for (int i = 0; i < 8; ++i) { pm = fmaxf(pm, a[i]);
                pref[(size_t)(1 * 16 + bh) * SEQ + s0 + i] = v[i]; pref[(size_t)(2 * 16 + bh) * SEQ + s0 + i] = a[i]; pref[(size_t)(3 * 16 + bh) * SEQ + s0 + i] = pm; }
        }
        __syncthreads();
    }
    const int gw = F.vcu * NWAVES + wave, NGW = F.G * NWAVES;
    const float inv = __builtin_amdgcn_exp2f(-(float)lane * (13.287712379549449f / 64.f));
    const float gq0 = P->in[I_FQN][l * HD + lane], gq1 = P->in[I_FQN][l * HD + 64 + lane], gk0 = P->in[I_FKN][l * HD + lane], gk1 = P->in[I_FKN][l * HD + 64 + lane];
    const float* cw = P->in[I_CONVW] + (size_t)l * 3 * 512; const float* gcv = P->in[I_HNG] + (size_t)l * DM + 1536;
    for (int m = gw; m < T; m += NGW) {
        bf16_t* zr = z + (size_t)m * NZ;
        const float ang = (float)((const int*)P->in[I_POS])[m] * inv;
        const float C1 = 0.15915493667125702f, C2 = 6.420638326565253e-09f;
        const float hi = ang * C1, lo = __builtin_fmaf(ang, C1, -hi);
        const float rev = (hi - __builtin_floorf(hi)) + (lo + ang * C2);
        const float cs = __builtin_amdgcn_cosf(rev), sn = __builtin_amdgcn_sinf(rev);
#pragma unroll
        for (int qk = 0; qk < 2; ++qk)
#pragma unroll
            for (int h = 0; h < NH; ++h) { bf16_t* p = zr + (qk ? ZK_R : ZQ_R) + h * HD + lane;
                const float t1 = bf2f(p[0]), t2 = bf2f(p[64]);
                p[0] = (bf16_t)f2bf(t1 * cs - t2 * sn); p[64] = (bf16_t)f2bf(t1 * sn + t2 * cs); }
#pragma unroll
        for (int qk = 0; qk < 2; ++qk)
#pragma unroll
            for (int h = 0; h < NH; ++h) { bf16_t* p = zr + (qk ? ZK_F : ZQ_F) + h * HD + lane;
                const float t1 = bf2f(p[0]), t2 = bf2f(p[64]);
                const float rstd = __builtin_amdgcn_rsqf(wave_sum(t1 * t1 + t2 * t2) * (1.f / HD) + EPS);
                p[0] = (bf16_t)f2bf(t1 * rstd * (qk ? gk0 : gq0)); p[64] = (bf16_t)f2bf(t2 * rstd * (qk ? gk1 : gq1)); }
        { const int s = m & (SEQ - 1), c0 = 8 * lane;
            float u[3][8];
#pragma unroll
            for (int d = 0; d < 3; ++d) {
                if (s - (2 - d) >= 0) { const bf16_t* zz = zr - (size_t)(2 - d) * NZ;
                    const u32x4 hc = *(const u32x4*)(zz + ZH_C + c0), cc = *(const u32x4*)(zz + ZC_C + c0);
                    u[d][0] = bflo(hc.x) * bflo(cc.x); u[d][1] = bfhi(hc.x) * bfhi(cc.x); u[d][2] = bflo(hc.y) * bflo(cc.y); u[d][3] = bfhi(hc.y) * bfhi(cc.y);
                    u[d][4] = bflo(hc.z) * bflo(cc.z); u[d][5] = bfhi(hc.z) * bfhi(cc.z); u[d][6] = bflo(hc.w) * bflo(cc.w); u[d][7] = bfhi(hc.w) * bfhi(cc.w);
                } else {
#pragma unroll
                    for (int i = 0; i < 8; ++i) u[d][i] = 0.f; }
            }
            const u32x4 cb = *(const u32x4*)(zr + ZB_C + c0);
            const float cbv[8] = {bflo(cb.x), bfhi(cb.x), bflo(cb.y), bfhi(cb.y), bflo(cb.z), bfhi(cb.z), bflo(cb.w), bfhi(cb.w)};
            float o[8], ss = 0.f;
#pragma unroll
            for (int i = 0; i < 8; ++i) { o[i] = cbv[i] * (cw[c0 + i] * u[0][i] + cw[512 + c0 + i] * u[1][i] + cw[1024 + c0 + i] * u[2][i]); ss += o[i] * o[i]; }
            ss += __shfl_xor(ss, 1); ss += __shfl_xor(ss, 2); ss += __shfl_xor(ss, 4); ss += __shfl_xor(ss, 8);
            const float rstd = __builtin_amdgcn_rsqf(ss * (1.f / HD) + EPS);
            u32x4 w; w.x = pk2(o[0] * rstd * gcv[c0 + 0], o[1] * rstd * gcv[c0 + 1]); w.y = pk2(o[2] * rstd * gcv[c0 + 2], o[3] * rstd * gcv[c0 + 3]);
            w.z = pk2(o[4] * rstd * gcv[c0 + 4], o[5] * rstd * gcv[c0 + 5]); w.w = pk2(o[6] * rstd * gcv[c0 + 6], o[7] * rstd * gcv[c0 + 7]);
            *(u32x4*)(y + (size_t)m * DM + 1536 + c0) = w; }
    }
}

__device__ __forceinline__ void phase_mix_naive(Frame& F, int l) {
    PHASE_BEGIN();
    const bf16_t* z = (const bf16_t*)(ws + WS_Z);
    bf16_t* y = (bf16_t*)(ws + WS_Y);
    const float* pref = (const float*)(ws + WS_PREF);
    LAS float* qs = (LAS float*)F.lds; LAS float* ks = qs + 64 * 132; LAS float* vs = ks + 64 * 132; LAS float* ps = vs + 64 * 128;
    LAS float* rowA = ps + 64 * 68; LAS float* rowB = rowA + 64; LAS float* colA = rowB + 64;
    const int lr = tid >> 3, ldc = (tid & 7) * 16;
    const int rg = tid >> 4, cg = tid & 15;
    const int rg2 = tid >> 5, eg = tid & 31;
    const float kscale = 0.08838834764831845f;
    for (int it = F.vcu; it < 3 * 16 * 64; it += F.G) {
        const int tb = 63 - it / 48, rem = it % 48, mx = rem >> 4, bh = rem & 15, b = bh >> 2, h = bh & 3, t0 = tb * 64;
        const int qcol = (mx == 0 ? ZQ_R : (mx == 1 ? ZQ_F : ZQ_M)) + h * HD, kcol = (mx == 0 ? ZK_R : (mx == 1 ? ZK_F : ZK_M)) + h * HD, vcol = (mx == 0 ? ZV_R : (mx == 1 ? ZV_F : ZV_M)) + h * HD;
        const float lg2g = __builtin_log2f(1.0f - __builtin_amdgcn_exp2f(-5.0f - (float)h));
        __syncthreads();
        { const bf16_t* src = z + (size_t)(b * SEQ + t0 + lr) * NZ + qcol + ldc; const u32x4 a = *(const u32x4*)src, c = *(const u32x4*)(src + 8);
            LAS f32x4* d = (LAS f32x4*)(qs + lr * 132 + ldc);
            d[0] = (f32x4){bflo(a.x), bfhi(a.x), bflo(a.y), bfhi(a.y)}; d[1] = (f32x4){bflo(a.z), bfhi(a.z), bflo(a.w), bfhi(a.w)};
            d[2] = (f32x4){bflo(c.x), bfhi(c.x), bflo(c.y), bfhi(c.y)}; d[3] = (f32x4){bflo(c.z), bfhi(c.z), bflo(c.w), bfhi(c.w)}; }
        if (tid < 64) { const int t = t0 + tid;
            rowA[tid] = mx == 1 ? pref[(size_t)(0 * 16 + bh) * SEQ + t] : (mx == 2 ? pref[(size_t)(3 * 16 + bh) * SEQ + t] : 0.f);
            rowB[tid] = mx == 2 ? pref[(size_t)(1 * 16 + bh) * SEQ + t] : 0.f; }
        f32x4 acc[4]; float rsum[4];
#pragma unroll
        for (int a = 0; a < 4; ++a) { acc[a] = (f32x4){0.f, 0.f, 0.f, 0.f}; rsum[a] = 0.f; }
        for (int kt = 0; kt <= tb; ++kt) {
            const int j0 = kt * 64;
            __syncthreads();
            { const bf16_t* src = z + (size_t)(b * SEQ + j0 + lr) * NZ + kcol + ldc; const u32x4 a = *(const u32x4*)src, c = *(const u32x4*)(src + 8);
                LAS f32x4* d = (LAS f32x4*)(ks + lr * 132 + ldc);
                d[0] = (f32x4){bflo(a.x), bfhi(a.x), bflo(a.y), bfhi(a.y)}; d[1] = (f32x4){bflo(a.z), bfhi(a.z), bflo(a.w), bfhi(a.w)};
                d[2] = (f32x4){bflo(c.x), bfhi(c.x), bflo(c.y), bfhi(c.y)}; d[3] = (f32x4){bflo(c.z), bfhi(c.z), bflo(c.w), bfhi(c.w)}; }
            { const bf16_t* src = z + (size_t)(b * SEQ + j0 + lr) * NZ + vcol + ldc; const u32x4 a = *(const u32x4*)src, c = *(const u32x4*)(src + 8);
                LAS f32x4* d = (LAS f32x4*)(vs + lr * 128 + ldc);
                d[0] = (f32x4){bflo(a.x), bfhi(a.x), bflo(a.y), bfhi(a.y)}; d[1] = (f32x4){bflo(a.z), bfhi(a.z), bflo(a.w), bfhi(a.w)};
                d[2] = (f32x4){bflo(c.x), bfhi(c.x), bflo(c.y), bfhi(c.y)}; d[3] = (f32x4){bflo(c.z), bfhi(c.z), bflo(c.w), bfhi(c.w)}; }
            if (tid < 64) colA[tid] = mx == 1 ? pref[(size_t)(0 * 16 + bh) * SEQ + j0 + tid] : (mx == 2 ? pref[(size_t)(2 * 16 + bh) * SEQ + j0 + tid] : 0.f);
            __syncthreads();
            float dot[2][4];
#pragma unroll
            for (int a = 0; a < 2; ++a)
#pragma unroll
                for (int i = 0; i < 4; ++i) dot[a][i] = 0.f;
#pragma unroll 4
            for (int d4 = 0; d4 < 32; ++d4) {
                const f32x4 qa = *(const LAS f32x4*)(qs + (2 * rg) * 132 + 4 * d4), qb = *(const LAS f32x4*)(qs + (2 * rg + 1) * 132 + 4 * d4);
#pragma unroll
                for (int i = 0; i < 4; ++i) { const f32x4 kk = *(const LAS f32x4*)(ks + (4 * cg + i) * 132 + 4 * d4);
                    dot[0][i] += (qa.x * kk.x + qa.y * kk.y) + (qa.z * kk.z + qa.w * kk.w); dot[1][i] += (qb.x * kk.x + qb.y * kk.y) + (qb.z * kk.z + qb.w * kk.w); }
            }
#pragma unroll
            for (int a = 0; a < 2; ++a) { const int r = 2 * rg + a, t = t0 + r; const float ra = rowA[r];
                f32x4 pv;
#pragma unroll
                for (int i = 0; i < 4; ++i) { const int j = 4 * cg + i, jg = j0 + j; float p;
                    if (mx == 0) p = dot[a][i] * kscale * __builtin_amdgcn_exp2f((float)(t - jg) * lg2g);
                    else if (mx == 1) p = __expf(dot[a][i] * kscale + ra - colA[j]);
                    else p = dot[a][i] * kscale * __expf(colA[j] - ra);
                    pv[i] = jg <= t ? p : 0.f; }
                *(LAS f32x4*)(ps + r * 68 + 4 * cg) = pv; }
            __syncthreads();
#pragma unroll 4
            for (int j4 = 0; j4 < 16; ++j4) {
                f32x4 pp[4];
#pragma unroll
                for (int a = 0; a < 4; ++a) pp[a] = *(const LAS f32x4*)(ps + (4 * rg2 + a) * 68 + 4 * j4);
#pragma unroll
                for (int jj = 0; jj < 4; ++jj) { const f32x4 vv = *(const LAS f32x4*)(vs + (4 * j4 + jj) * 128 + 4 * eg);
#pragma unroll
                    for (int a = 0; a < 4; ++a) { acc[a] += pp[a][jj] * vv; rsum[a] += pp[a][jj]; } }
            }
        }
        const float* gn = P->in[I_HNG] + (size_t)l * DM + mx * 512 + h * HD + 4 * eg;
#pragma unroll
        for (int a = 0; a < 4; ++a) { const int r = 4 * rg2 + a; const size_t m = (size_t)b * SEQ + t0 + r;
            f32x4 o = acc[a];
            if (mx == 1) o = o * (1.0f / rsum[a]);
            if (mx == 2) { const float den = fmaxf(fabsf(rsum[a]), __expf(-rowB[r] - rowA[r])); o = o * (1.0f / den);
                const u32x2 g = *(const u32x2*)(z + m * NZ + ZO_M + h * HD + 4 * eg);
                o.x *= sigmoidf_(bflo(g.x)); o.y *= sigmoidf_(bfhi(g.x)); o.z *= sigmoidf_(bflo(g.y)); o.w *= sigmoidf_(bfhi(g.y)); }
            float ss = (o.x * o.x + o.y * o.y) + (o.z * o.z + o.w * o.w);
            ss += __shfl_xor(ss, 1); ss += __shfl_xor(ss, 2); ss += __shfl_xor(ss, 4); ss += __shfl_xor(ss, 8); ss += __shfl_xor(ss, 16);
            const float rstd = __builtin_amdgcn_rsqf(ss * (1.f / HD) + EPS);
            o = o * rstd; o.x *= gn[0]; o.y *= gn[1]; o.z *= gn[2]; o.w *= gn[3];
            if (mx == 0) { const u32x2 g = *(const u32x2*)(z + m * NZ + ZG_R + h * HD + 4 * eg);
                o.x *= siluf_(bflo(g.x)); o.y *= siluf_(bfhi(g.x)); o.z *= siluf_(bflo(g.y)); o.w *= siluf_(bfhi(g.y)); }
            u32x2 w; w.x = pk2(o.x, o.y); w.y = pk2(o.z, o.w);
            *(u32x2*)(y + m * DM + mx * 512 + h * HD + 4 * eg) = w; }
    }
}


constexpr int TS = 136, TILE_B = 128 * TS * 2;
typedef short s16x4 __attribute__((ext_vector_type(4)));
constexpr size_t WS_KV = WS_STATE;
constexpr size_t WS_NB = WS_KV + (size_t)2 * 16 * 32 * 16384 * 4;
constexpr size_t WS_MS = WS_NB + (size_t)16 * 32 * 128 * 4;
static_assert(WS_MS + 16 * 32 * 4 * 4 <= WS_END, "state scratch");
__device__ __forceinline__ bf16x8 frag_row(const LAS bf16_t* T, int row, int k0) { return *(const LAS bf16x8*)(T + row * TS + k0); }
__device__ __forceinline__ bf16x8 frag_tr2(const LAS bf16_t* T, int rA, int rB, int c0, int lane) {
    const int i = lane & 15, q = i >> 2, p = i & 3;
    const s16x4 a = __builtin_amdgcn_ds_read_tr16_b64_v4i16((LAS s16x4*)(T + (rA + q) * TS + c0 + 4 * p));
    const s16x4 b = __builtin_amdgcn_ds_read_tr16_b64_v4i16((LAS s16x4*)(T + (rB + q) * TS + c0 + 4 * p));
    return (bf16x8){a[0], a[1], a[2], a[3], b[0], b[1], b[2], b[3]};
}
__device__ __forceinline__ bf16x8 frag_tr(const LAS bf16_t* T, int k0, int c0, int lane) { const int g = lane >> 4; return frag_tr2(T, k0 + 8 * g, k0 + 8 * g + 4, c0, lane); }
__device__ __forceinline__ bf16x8 frag_trp(const LAS bf16_t* T, int s, int c0, int lane) { const int g = lane >> 4; return frag_tr2(T, 32 * s + 4 * g, 32 * s + 16 + 4 * g, c0, lane); }
__device__ __forceinline__ bf16x8 pack_acc(const f32x4 a, const f32x4 b) { u32x4 w; w.x = pk2(a[0], a[1]); w.y = pk2(a[2], a[3]); w.z = pk2(b[0], b[1]); w.w = pk2(b[2], b[3]); return __builtin_bit_cast(bf16x8, w); }
#define MFMA16(a, b, c) __builtin_amdgcn_mfma_f32_16x16x32_bf16((a), (b), (c), 0, 0, 0)
__device__ __forceinline__ void tile_load(LAS bf16_t* Tl, const bf16_t* src, int tid) {
    const int row = tid >> 2, c = (tid & 3) * 32; const u32x4* s = (const u32x4*)(src + (size_t)row * NZ + c); LAS u32x4* d = (LAS u32x4*)(Tl + row * TS + c);
    const u32x4 v0 = s[0], v1 = s[1], v2 = s[2], v3 = s[3]; d[0] = v0; d[1] = v1; d[2] = v2; d[3] = v3;
}
struct ChunkGates { float b0, b1, a0, a1, bL; };
__device__ __forceinline__ ChunkGates chunk_gates(const float* gates, int row0, int h, float mfb, float mib, int lane) {
    const float* g0 = gates + (size_t)(row0 + 2 * lane) * 12;
    const float lf0 = log_sigmoidf_(g0[8 + h] + mfb), lf1 = log_sigmoidf_(g0[12 + 8 + h] + mfb);
    const float s = lf0 + lf1; float inc = s;
#pragma unroll
    for (int o = 1; o < 64; o <<= 1) { const float t = __shfl_up(inc, o); if (lane >= o) inc += t; }
    ChunkGates cg; cg.b0 = inc - s + lf0; cg.b1 = inc; cg.bL = __shfl(inc, 63);
    cg.a0 = g0[4 + h] + mib - cg.b0; cg.a1 = g0[12 + 4 + h] + mib - cg.b1; return cg;
}

__device__ __forceinline__ void phase_c1(Frame& F, int l) {
    PHASE_BEGIN();
    bf16_t* z = (bf16_t*)(ws + WS_Z);
    bf16_t* y = (bf16_t*)(ws + WS_Y);
    const float* gates = (const float*)(ws + WS_GATES);
    float* pref = (float*)(ws + WS_PREF);
    for (int it = F.vcu; it < 16; it += F.G) {
        const int bh = it, b = bh >> 2, h = bh & 3; LAS float* sc = (LAS float*)(F.lds + 65536); const int s0 = tid * 8; float v[8];
        const float fb = P->in[I_FFB][l * NH + h]; float run = 0.f;
#pragma unroll
        for (int i = 0; i < 8; ++i) { run += log_sigmoidf_(gates[(size_t)(b * SEQ + s0 + i) * 12 + h] + fb); v[i] = run; }
        const float base = block_excl_sum(lane, wave, run, sc);
#pragma unroll
        for (int i = 0; i < 8; ++i) pref[(size_t)bh * SEQ + s0 + i] = (base + v[i]) * 1.4426950408889634f;
        __syncthreads();
    }
    {
        const int gw = F.vcu * NWAVES + wave, NGW = F.G * NWAVES;
        const float gq0 = P->in[I_FQN][l * HD + lane], gq1 = P->in[I_FQN][l * HD + 64 + lane], gk0 = P->in[I_FKN][l * HD + lane], gk1 = P->in[I_FKN][l * HD + 64 + lane];
        const float* cw = P->in[I_CONVW] + (size_t)l * 3 * 512; const float* gcv = P->in[I_HNG] + (size_t)l * DM + 1536;
        for (int m = gw; m < T; m += NGW) {
            bf16_t* zr = z + (size_t)m * NZ;
#pragma unroll
            for (int qk = 0; qk < 2; ++qk)
#pragma unroll
                for (int h = 0; h < NH; ++h) { bf16_t* p = zr + (qk ? ZK_F : ZQ_F) + h * HD + lane;
                    const float t1 = bf2f(p[0]), t2 = bf2f(p[64]);
                    const float rstd = __builtin_amdgcn_rsqf(wave_sum(t1 * t1 + t2 * t2) * (1.f / HD) + EPS);
                    p[0] = (bf16_t)f2bf(t1 * rstd * (qk ? gk0 : gq0)); p[64] = (bf16_t)f2bf(t2 * rstd * (qk ? gk1 : gq1)); }
            { const int s = m & (SEQ - 1), c0 = 8 * lane;
                float u[3][8];
#pragma unroll
                for (int d = 0; d < 3; ++d) {
                    if (s - (2 - d) >= 0) { const bf16_t* zz = zr - (size_t)(2 - d) * NZ;
                        const u32x4 hc = *(const u32x4*)(zz + ZH_C + c0), cc = *(const u32x4*)(zz + ZC_C + c0);
                        u[d][0] = bflo(hc.x) * bflo(cc.x); u[d][1] = bfhi(hc.x) * bfhi(cc.x); u[d][2] = bflo(hc.y) * bflo(cc.y); u[d][3] = bfhi(hc.y) * bfhi(cc.y);
                        u[d][4] = bflo(hc.z) * bflo(cc.z); u[d][5] = bfhi(hc.z) * bfhi(cc.z); u[d][6] = bflo(hc.w) * bflo(cc.w); u[d][7] = bfhi(hc.w) * bfhi(cc.w);
                    } else {
#pragma unroll
                        for (int i = 0; i < 8; ++i) u[d][i] = 0.f; }
                }
                const u32x4 cb = *(const u32x4*)(zr + ZB_C + c0);
                const float cbv[8] = {bflo(cb.x), bfhi(cb.x), bflo(cb.y), bfhi(cb.y), bflo(cb.z), bfhi(cb.z), bflo(cb.w), bfhi(cb.w)};
                float o[8], ss = 0.f;
#pragma unroll
                for (int i = 0; i < 8; ++i) { o[i] = cbv[i] * (cw[c0 + i] * u[0][i] + cw[512 + c0 + i] * u[1][i] + cw[1024 + c0 + i] * u[2][i]); ss += o[i] * o[i]; }
                ss += __shfl_xor(ss, 1); ss += __shfl_xor(ss, 2); ss += __shfl_xor(ss, 4); ss += __shfl_xor(ss, 8);
                const float rstd = __builtin_amdgcn_rsqf(ss * (1.f / HD) + EPS);
                u32x4 w; w.x = pk2(o[0] * rstd * gcv[c0 + 0], o[1] * rstd * gcv[c0 + 1]); w.y = pk2(o[2] * rstd * gcv[c0 + 2], o[3] * rstd * gcv[c0 + 3]);
                w.z = pk2(o[4] * rstd * gcv[c0 + 4], o[5] * rstd * gcv[c0 + 5]); w.w = pk2(o[6] * rstd * gcv[c0 + 6], o[7] * rstd * gcv[c0 + 7]);
                *(u32x4*)(y + (size_t)m * DM + 1536 + c0) = w; }
        }
    }
    LAS bf16_t* Kt = (LAS bf16_t*)F.lds; LAS bf16_t* Vt = Kt + 128 * TS; LAS float* wj = (LAS float*)(F.lds + 2 * TILE_B);
    float* KV = (float*)(ws + WS_KV); float* NB = (float*)(ws + WS_NB); float* MS = (float*)(ws + WS_MS);
    const float kscale = 0.08838834764831845f;
    for (int it = F.vcu; it < 2 * 16 * 32; it += F.G) {
        const int kind = it >> 9, bh = (it >> 5) & 15, n = it & 31, b = bh >> 2, h = bh & 3, row0 = b * SEQ + n * 128;
        __syncthreads();
        const int row = tid >> 2;
        if (kind == 0) {
            const int i0 = (tid & 3) * 16; bf16_t* zr = z + (size_t)(row0 + row) * NZ;
            const float posf = (float)((const int*)P->in[I_POS])[row0 + row];
            const float lg2g = __builtin_log2f(1.0f - __builtin_amdgcn_exp2f(-5.0f - (float)h));
            const float kw = kscale * __builtin_amdgcn_exp2f((float)(127 - row) * lg2g);
            float cs[16], sn[16];
#pragma unroll
            for (int ii = 0; ii < 16; ++ii) { const float inv = __builtin_amdgcn_exp2f(-(float)(i0 + ii) * (13.287712379549449f / 64.f)); const float ang = posf * inv;
                const float C1 = 0.15915493667125702f, C2 = 6.420638326565253e-09f; const float hi = ang * C1, lo = __builtin_fmaf(ang, C1, -hi); const float rev = (hi - __builtin_floorf(hi)) + (lo + ang * C2);
                cs[ii] = __builtin_amdgcn_cosf(rev); sn[ii] = __builtin_amdgcn_sinf(rev); }
#pragma unroll
            for (int qk = 0; qk < 2; ++qk) { bf16_t* p = zr + (qk ? ZK_R : ZQ_R) + h * HD + i0;
                const u32x4 a0 = *(const u32x4*)p, a1 = *(const u32x4*)(p + 8), b0 = *(const u32x4*)(p + 64), b1 = *(const u32x4*)(p + 72);
                const unsigned aw[8] = {a0.x, a0.y, a0.z, a0.w, a1.x, a1.y, a1.z, a1.w}, bw[8] = {b0.x, b0.y, b0.z, b0.w, b1.x, b1.y, b1.z, b1.w};
                unsigned oa[8], ob[8], ka[8], kb[8];
#pragma unroll
                for (int w2 = 0; w2 < 8; ++w2) { const float t1l = bflo(aw[w2]), t1h = bfhi(aw[w2]), t2l = bflo(bw[w2]), t2h = bfhi(bw[w2]);
                    const float r1l = t1l * cs[2 * w2] - t2l * sn[2 * w2], r1h = t1h * cs[2 * w2 + 1] - t2h * sn[2 * w2 + 1];
                    const float r2l = t1l * sn[2 * w2] + t2l * cs[2 * w2], r2h = t1h * sn[2 * w2 + 1] + t2h * cs[2 * w2 + 1];
                    oa[w2] = pk2(r1l, r1h); ob[w2] = pk2(r2l, r2h);
                    ka[w2] = pk2(bflo(oa[w2]) * kw, bfhi(oa[w2]) * kw); kb[w2] = pk2(bflo(ob[w2]) * kw, bfhi(ob[w2]) * kw); }
                *(u32x4*)p = (u32x4){oa[0], oa[1], oa[2], oa[3]}; *(u32x4*)(p + 8) = (u32x4){oa[4], oa[5], oa[6], oa[7]};
                *(u32x4*)(p + 64) = (u32x4){ob[0], ob[1], ob[2], ob[3]}; *(u32x4*)(p + 72) = (u32x4){ob[4], ob[5], ob[6], ob[7]};
                if (qk) { LAS u32x4* d = (LAS u32x4*)(Kt + row * TS + i0); d[0] = (u32x4){ka[0], ka[1], ka[2], ka[3]}; d[1] = (u32x4){ka[4], ka[5], ka[6], ka[7]};
                    LAS u32x4* d2 = (LAS u32x4*)(Kt + row * TS + 64 + i0); d2[0] = (u32x4){kb[0], kb[1], kb[2], kb[3]}; d2[1] = (u32x4){kb[4], kb[5], kb[6], kb[7]}; } }
            tile_load(Vt, z + (size_t)row0 * NZ + ZV_R + h * HD, tid);
        } else {
            if (wave == 0) { const ChunkGates cg = chunk_gates(gates, row0, h, P->in[I_MFB][l * NH + h], P->in[I_MIB][l * NH + h], lane);
                float amax = fmaxf(cg.a0, cg.a1);
#pragma unroll
                for (int o = 1; o < 64; o <<= 1) amax = fmaxf(amax, __shfl_xor(amax, o));
                wj[2 * lane] = kscale * __expf(cg.a0 - amax); wj[2 * lane + 1] = kscale * __expf(cg.a1 - amax);
                if (lane == 0) { MS[(size_t)(bh * 32 + n) * 4 + 0] = cg.bL + amax; MS[(size_t)(bh * 32 + n) * 4 + 1] = cg.bL; } }
            __syncthreads();
            { const int c = (tid & 3) * 32; const float w = wj[row]; const u32x4* s = (const u32x4*)(z + (size_t)(row0 + row) * NZ + ZK_M + h * HD + c); LAS u32x4* d = (LAS u32x4*)(Kt + row * TS + c);
#pragma unroll
                for (int q = 0; q < 4; ++q) { const u32x4 v = s[q]; u32x4 o; o.x = pk2(bflo(v.x) * w, bfhi(v.x) * w); o.y = pk2(bflo(v.y) * w, bfhi(v.y) * w); o.z = pk2(bflo(v.z) * w, bfhi(v.z) * w); o.w = pk2(bflo(v.w) * w, bfhi(v.w) * w); d[q] = o; } }
            tile_load(Vt, z + (size_t)row0 * NZ + ZV_M + h * HD, tid);
        }
        __syncthreads();
        { f32x4 acc[8];
#pragma unroll
            for (int nt = 0; nt < 8; ++nt) acc[nt] = (f32x4){0.f, 0.f, 0.f, 0.f};
            const int d0 = 16 * wave;
#pragma unroll
            for (int ks = 0; ks < 4; ++ks) { const bf16x8 A = frag_tr(Kt, 32 * ks, d0, lane);
#pragma unroll
                for (int nt = 0; nt < 8; ++nt) { const bf16x8 B = frag_tr(Vt, 32 * ks, 16 * nt, lane); acc[nt] = MFMA16(A, B, acc[nt]); } }
            float* kv = KV + ((size_t)(kind * 16 + bh) * 32 + n) * 16384; const int g = lane >> 4, i = lane & 15;
#pragma unroll
            for (int nt = 0; nt < 8; ++nt)
#pragma unroll
                for (int r = 0; r < 4; ++r) kv[(d0 + 4 * g + r) * 128 + 16 * nt + i] = acc[nt][r];
            if (kind == 1 && tid < 128) { float sacc = 0.f; for (int j = 0; j < 128; ++j) sacc += bf2f(Kt[j * TS + tid]); NB[(size_t)(bh * 32 + n) * 128 + tid] = sacc; }
        }
    }
}

__device__ __forceinline__ void fox_block(Frame& F, int l, int bh, int qb, const KArgs P, unsigned char* ws, int tid, int lane, int wave) {
    const bf16_t* z = (const bf16_t*)(ws + WS_Z); bf16_t* y = (bf16_t*)(ws + WS_Y); const float* pref = (const float*)(ws + WS_PREF);
    LAS bf16_t* Kt = (LAS bf16_t*)F.lds; LAS bf16_t* Vt = Kt + 128 * TS; LAS float* Fj = (LAS float*)(F.lds + 2 * TILE_B);
    const int b = bh >> 2, h = bh & 3, g = lane >> 4, il = 16 * wave + (lane & 15), irow = qb * 128 + il; const size_t grow = (size_t)b * SEQ + irow;
    bf16x8 qf[4];
#pragma unroll
    for (int ks = 0; ks < 4; ++ks) qf[ks] = *(const bf16x8*)(z + grow * NZ + ZQ_F + h * HD + 32 * ks + 8 * g);
    const float F2i = pref[(size_t)bh * SEQ + irow];
    float mi = -1.0e30f, li = 0.f; f32x4 o[8];
#pragma unroll
    for (int mt = 0; mt < 8; ++mt) o[mt] = (f32x4){0.f, 0.f, 0.f, 0.f};
    const int lrow = tid >> 2, lc = (tid & 3) * 32;
    u32x4 pk[4], pv[4];
    { const u32x4* sk = (const u32x4*)(z + ((size_t)b * SEQ + lrow) * NZ + ZK_F + h * HD + lc); const u32x4* sv = (const u32x4*)(z + ((size_t)b * SEQ + lrow) * NZ + ZV_F + h * HD + lc);
#pragma unroll
        for (int q = 0; q < 4; ++q) { pk[q] = sk[q]; pv[q] = sv[q]; } }
    for (int kt = 0; kt <= qb; ++kt) {
        __syncthreads();
        { LAS u32x4* dk = (LAS u32x4*)(Kt + lrow * TS + lc); LAS u32x4* dv = (LAS u32x4*)(Vt + lrow * TS + lc);
#pragma unroll
            for (int q = 0; q < 4; ++q) { dk[q] = pk[q]; dv[q] = pv[q]; } }
        if (tid < 128) Fj[tid] = pref[(size_t)bh * SEQ + kt * 128 + tid];
        __syncthreads();
        if (kt < qb) { const u32x4* sk = (const u32x4*)(z + ((size_t)b * SEQ + (kt + 1) * 128 + lrow) * NZ + ZK_F + h * HD + lc); const u32x4* sv = (const u32x4*)(z + ((size_t)b * SEQ + (kt + 1) * 128 + lrow) * NZ + ZV_F + h * HD + lc);
#pragma unroll
            for (int q = 0; q < 4; ++q) { pk[q] = sk[q]; pv[q] = sv[q]; } }
        f32x4 st[8]; float mx = -INFINITY;
#pragma unroll
        for (int mt = 0; mt < 8; ++mt) { f32x4 a = (f32x4){0.f, 0.f, 0.f, 0.f};
#pragma unroll
            for (int ks = 0; ks < 4; ++ks) a = MFMA16(frag_row(Kt, 16 * mt + (lane & 15), 32 * ks + 8 * g), qf[ks], a);
            const f32x4 fj = *(const LAS f32x4*)(Fj + 16 * mt + 4 * g);
#pragma unroll
            for (int r = 0; r < 4; ++r) { float x = a[r] * 0.12751743074602467f + (F2i - fj[r]); if (kt == qb && (16 * mt + 4 * g + r) > il) x = -INFINITY; a[r] = x; mx = fmaxf(mx, x); }
            st[mt] = a; }
        mx = fmaxf(mx, __shfl_xor(mx, 16)); mx = fmaxf(mx, __shfl_xor(mx, 32));
        const float mn = fmaxf(mi, mx), alpha = __builtin_amdgcn_exp2f(mi - mn); float ps = 0.f;
#pragma unroll
        for (int mt = 0; mt < 8; ++mt)
#pragma unroll
            for (int r = 0; r < 4; ++r) { const float p = __builtin_amdgcn_exp2f(st[mt][r] - mn); st[mt][r] = p; ps += p; }
        ps += __shfl_xor(ps, 16); ps += __shfl_xor(ps, 32);
        li = li * alpha + ps; mi = mn;
        bf16x8 pf[4];
#pragma unroll
        for (int s2 = 0; s2 < 4; ++s2) pf[s2] = pack_acc(st[2 * s2], st[2 * s2 + 1]);
#pragma unroll
        for (int mt = 0; mt < 8; ++mt) { f32x4 a = o[mt] * alpha;
#pragma unroll
            for (int s2 = 0; s2 < 4; ++s2) a = MFMA16(frag_trp(Vt, s2, 16 * mt, lane), pf[s2], a);
            o[mt] = a; }
    }
    const float invl = 1.0f / li; float ss = 0.f;
#pragma unroll
    for (int mt = 0; mt < 8; ++mt) { o[mt] = o[mt] * invl; ss += (o[mt][0] * o[mt][0] + o[mt][1] * o[mt][1]) + (o[mt][2] * o[mt][2] + o[mt][3] * o[mt][3]); }
    ss += __shfl_xor(ss, 16); ss += __shfl_xor(ss, 32);
    const float rstd = __builtin_amdgcn_rsqf(ss * (1.f / HD) + EPS);
    const float* gn = P->in[I_HNG] + (size_t)l * DM + 512 + h * HD;
#pragma unroll
    for (int mt = 0; mt < 8; ++mt) { const int e0 = 16 * mt + 4 * g; const f32x4 gv = *(const f32x4*)(gn + e0);
        u32x2 w; w.x = pk2(o[mt][0] * rstd * gv[0], o[mt][1] * rstd * gv[1]); w.y = pk2(o[mt][2] * rstd * gv[2], o[mt][3] * rstd * gv[3]);
        *(u32x2*)(y + grow * DM + 512 + h * HD + e0) = w; }
}

__device__ __forceinline__ void phase_c2(Frame& F, int l) {
    PHASE_BEGIN();
    float* KV = (float*)(ws + WS_KV); float* NB = (float*)(ws + WS_NB); float* MS = (float*)(ws + WS_MS);
    for (unsigned gidx = (unsigned)F.vcu * 512u + (unsigned)tid; gidx < 2u * 16u * 4096u; gidx += (unsigned)F.G * 512u) {
        const int kind = gidx >> 16, bh = (gidx >> 12) & 15, q4 = gidx & 4095, h = bh & 3;
        f32x4* base = (f32x4*)(KV + (size_t)(kind * 16 + bh) * 32 * 16384) + q4;
        f32x4 S = (f32x4){0.f, 0.f, 0.f, 0.f};
        if (kind == 0) {
            const float dec = __builtin_amdgcn_exp2f(128.0f * __builtin_log2f(1.0f - __builtin_amdgcn_exp2f(-5.0f - (float)h)));
#pragma unroll 8
            for (int n = 0; n < 32; ++n) { const f32x4 kv = base[(size_t)n * 4096]; base[(size_t)n * 4096] = S; S = S * dec + kv; }
        } else {
            const bool donb = q4 < 32; f32x4* nb = (f32x4*)(NB + (size_t)bh * 32 * 128) + q4; f32x4 Nn = (f32x4){0.f, 0.f, 0.f, 0.f};
            float m = 0.f;
#pragma unroll 4
            for (int n = 0; n < 32; ++n) { const f32x4 kv = base[(size_t)n * 4096]; const float mloc = MS[(size_t)(bh * 32 + n) * 4 + 0], bL = MS[(size_t)(bh * 32 + n) * 4 + 1];
                if (q4 == 0) MS[(size_t)(bh * 32 + n) * 4 + 2] = m;
                base[(size_t)n * 4096] = S;
                const float mn = fmaxf(bL + m, mloc), d0 = __expf(bL + m - mn), d1 = __expf(mloc - mn);
                S = S * d0 + kv * d1;
                if (donb) { const f32x4 nv = nb[(size_t)n * 32]; nb[(size_t)n * 32] = Nn; Nn = Nn * d0 + nv * d1; }
                m = mn; }
        }
    }
    for (int it = F.vcu; it < 16 * 16; it += F.G) { const int bh = it >> 4, p = it & 15;
        fox_block(F, l, bh, p, P, ws, tid, lane, wave);
        fox_block(F, l, bh, 31 - p, P, ws, tid, lane, wave); }
}

__device__ __forceinline__ void phase_c3(Frame& F, int l) {
    PHASE_BEGIN();
    const bf16_t* z = (const bf16_t*)(ws + WS_Z); bf16_t* y = (bf16_t*)(ws + WS_Y); const float* gates = (const float*)(ws + WS_GATES);
    const float* KV = (const float*)(ws + WS_KV); const float* NB = (const float*)(ws + WS_NB); const float* MS = (const float*)(ws + WS_MS);
    LAS bf16_t* Kt = (LAS bf16_t*)F.lds; LAS bf16_t* Vt = Kt + 128 * TS; LAS bf16_t* St = Vt + 128 * TS;
    LAS float* aj = (LAS float*)(F.lds + 3 * TILE_B); LAS float* bj = aj + 128; LAS float* Mj = bj + 128; LAS float* npv = Mj + 128;
    const float kscale = 0.08838834764831845f;
    const int g = lane >> 4, il = 16 * wave + (lane & 15);
    for (int it = F.vcu; it < 2 * 16 * 32; it += F.G) {
        const int kind = it >> 9, bh = (it >> 5) & 15, n = it & 31, b = bh >> 2, h = bh & 3, row0 = b * SEQ + n * 128;
        const int qcol = (kind ? ZQ_M : ZQ_R) + h * HD, kcol = (kind ? ZK_M : ZK_R) + h * HD, vcol = (kind ? ZV_M : ZV_R) + h * HD;
        __syncthreads();
        tile_load(Kt, z + (size_t)row0 * NZ + kcol, tid); tile_load(Vt, z + (size_t)row0 * NZ + vcol, tid);
        { const int row = tid >> 2, c = (tid & 3) * 32; const f32x4* s = (const f32x4*)(KV + ((size_t)(kind * 16 + bh) * 32 + n) * 16384 + row * 128 + c); LAS u32x4* d = (LAS u32x4*)(St + row * TS + c);
#pragma unroll
            for (int q = 0; q < 4; ++q) { const f32x4 v0 = s[2 * q], v1 = s[2 * q + 1]; u32x4 o; o.x = pk2(v0[0], v0[1]); o.y = pk2(v0[2], v0[3]); o.z = pk2(v1[0], v1[1]); o.w = pk2(v1[2], v1[3]); d[q] = o; } }
        float mprev = 0.f;
        if (kind == 1) { mprev = MS[(size_t)(bh * 32 + n) * 4 + 2];
            if (wave == 0) { const ChunkGates cg = chunk_gates(gates, row0, h, P->in[I_MFB][l * NH + h], P->in[I_MIB][l * NH + h], lane);
                float incm = fmaxf(cg.a0, cg.a1);
#pragma unroll
                for (int o = 1; o < 64; o <<= 1) { const float t = __shfl_up(incm, o); if (lane >= o) incm = fmaxf(incm, t); }
                const float prev = __shfl_up(incm, 1); const float exm = lane == 0 ? -INFINITY : prev;
                aj[2 * lane] = cg.a0; aj[2 * lane + 1] = cg.a1; bj[2 * lane] = cg.b0; bj[2 * lane + 1] = cg.b1;
                Mj[2 * lane] = fmaxf(fmaxf(exm, cg.a0), mprev); Mj[2 * lane + 1] = fmaxf(incm, mprev); }
            if (tid >= 128 && tid < 256) npv[tid - 128] = NB[(size_t)(bh * 32 + n) * 128 + (tid - 128)]; }
        __syncthreads();
        const size_t grow = (size_t)row0 + il;
        bf16x8 qf[4];
#pragma unroll
        for (int ks = 0; ks < 4; ++ks) qf[ks] = *(const bf16x8*)(z + grow * NZ + qcol + 32 * ks + 8 * g);
        const float lg2g = __builtin_log2f(1.0f - __builtin_amdgcn_exp2f(-5.0f - (float)h));
        const float Mi = kind ? Mj[il] : 0.f;
        f32x4 st[8]; float rsum = 0.f;
#pragma unroll
        for (int mt = 0; mt < 8; ++mt) { f32x4 a = (f32x4){0.f, 0.f, 0.f, 0.f};
#pragma unroll
            for (int ks = 0; ks < 4; ++ks) a = MFMA16(frag_row(Kt, 16 * mt + (lane & 15), 32 * ks + 8 * g), qf[ks], a);
            const f32x4 av = kind ? *(const LAS f32x4*)(aj + 16 * mt + 4 * g) : (f32x4){0.f, 0.f, 0.f, 0.f};
#pragma unroll
            for (int r = 0; r < 4; ++r) { const int j = 16 * mt + 4 * g + r;
                const float w = kind ? __expf(av[r] - Mi) : __builtin_amdgcn_exp2f((float)(il - j) * lg2g);
                const float p = j <= il ? a[r] * kscale * w : 0.f; a[r] = p; rsum += p; }
            st[mt] = a; }
        bf16x8 pf[4];
#pragma unroll
        for (int s2 = 0; s2 < 4; ++s2) pf[s2] = pack_acc(st[2 * s2], st[2 * s2 + 1]);
        const float cinter = kind ? __expf(mprev - Mi) : __builtin_amdgcn_exp2f((float)(il + 1) * lg2g);
        f32x4 o[8];
#pragma unroll
        for (int mt = 0; mt < 8; ++mt) { f32x4 a2 = (f32x4){0.f, 0.f, 0.f, 0.f};
#pragma unroll
            for (int ks = 0; ks < 4; ++ks) a2 = MFMA16(frag_tr(St, 32 * ks, 16 * mt, lane), qf[ks], a2);
            f32x4 a = a2 * cinter;
#pragma unroll
            for (int s2 = 0; s2 < 4; ++s2) a = MFMA16(frag_trp(Vt, s2, 16 * mt, lane), pf[s2], a);
            o[mt] = a; }
        if (kind == 1) {
            float qn = 0.f;
#pragma unroll
            for (int ks = 0; ks < 4; ++ks) { const u32x4 qw = __builtin_bit_cast(u32x4, qf[ks]); const f32x4 n0 = *(const LAS f32x4*)(npv + 32 * ks + 8 * g), n1 = *(const LAS f32x4*)(npv + 32 * ks + 8 * g + 4);
                qn += bflo(qw.x) * n0[0] + bfhi(qw.x) * n0[1] + bflo(qw.y) * n0[2] + bfhi(qw.y) * n0[3] + bflo(qw.z) * n1[0] + bfhi(qw.z) * n1[1] + bflo(qw.w) * n1[2] + bfhi(qw.w) * n1[3]; }
            qn += __shfl_xor(qn, 16); qn += __shfl_xor(qn, 32); rsum += __shfl_xor(rsum, 16); rsum += __shfl_xor(rsum, 32);
            const float den = fmaxf(fabsf(rsum + cinter * qn), __expf(-bj[il] - Mi)), iden = 1.0f / den;
#pragma unroll
            for (int mt = 0; mt < 8; ++mt) { const u32x2 gw2 = *(const u32x2*)(z + grow * NZ + ZO_M + h * HD + 16 * mt + 4 * g);
                o[mt][0] *= iden * sigmoidf_(bflo(gw2.x)); o[mt][1] *= iden * sigmoidf_(bfhi(gw2.x)); o[mt][2] *= iden * sigmoidf_(bflo(gw2.y)); o[mt][3] *= iden * sigmoidf_(bfhi(gw2.y)); }
        }
        float ss = 0.f;
#pragma unroll
        for (int mt = 0; mt < 8; ++mt) ss += (o[mt][0] * o[mt][0] + o[mt][1] * o[mt][1]) + (o[mt][2] * o[mt][2] + o[mt][3] * o[mt][3]);
        ss += __shfl_xor(ss, 16); ss += __shfl_xor(ss, 32);
        const float rstd = __builtin_amdgcn_rsqf(ss * (1.f / HD) + EPS);
        const int ycol = (kind ? 1024 : 0) + h * HD; const float* gn = P->in[I_HNG] + (size_t)l * DM + ycol;
#pragma unroll
        for (int mt = 0; mt < 8; ++mt) { const int e0 = 16 * mt + 4 * g; const f32x4 gv = *(const f32x4*)(gn + e0);
            float v0 = o[mt][0] * rstd * gv[0], v1 = o[mt][1] * rstd * gv[1], v2 = o[mt][2] * rstd * gv[2], v3 = o[mt][3] * rstd * gv[3];
            if (kind == 0) { const u32x2 gw2 = *(const u32x2*)(z + grow * NZ + ZG_R + h * HD + e0); v0 *= siluf_(bflo(gw2.x)); v1 *= siluf_(bfhi(gw2.x)); v2 *= siluf_(bflo(gw2.y)); v3 *= siluf_(bfhi(gw2.y)); }
            u32x2 w; w.x = pk2(v0, v1); w.y = pk2(v2, v3); *(u32x2*)(y + grow * DM + ycol + e0) = w; }
    }
}

__device__ __forceinline__ void phase_router(Frame& F, int l) {
    PHASE_BEGIN();
    const float* x1 = (const float*)(ws + WS_X1);
    bf16_t* hb = (bf16_t*)(ws + WS_HB);
    const float* rw = (const float*)(ws + WS_RW) + (size_t)l * 36 * DM;
    const float* g2 = P->in[I_N2G] + (size_t)l * DM;
    unsigned* gcnt = (unsigned*)(ws + WS_CTL) + CW_CNT + l * 64;
    unsigned* route = (unsigned*)(ws + WS_ROUTE);
    int* toklist = (int*)(ws + WS_TOK);
    LAS unsigned* lcnt = (LAS unsigned*)F.lds; LAS unsigned* lbase = lcnt + 32; LAS unsigned* rt = lbase + 32;
    float brg[4], bre[32];
#pragma unroll
    for (int i = 0; i < 4; ++i) brg[i] = P->in[I_BRG][l * 4 + i];
#pragma unroll
    for (int i = 0; i < 32; ++i) bre[i] = P->in[I_BRE][l * 32 + i];
    for (int bt = F.vcu; bt < T / 64; bt += F.G) {
        __syncthreads();
        if (tid < 32) lcnt[tid] = 0u;
        __syncthreads();
#pragma unroll 1
        for (int rr = 0; rr < 8; ++rr) {
            const int rl = wave * 8 + rr, m = bt * 64 + rl;
            const f32x4* xr = (const f32x4*)(x1 + (size_t)m * DM) + lane;
            f32x4 v[8]; float ss = 0.f;
#pragma unroll
            for (int j = 0; j < 8; ++j) { v[j] = xr[64 * j]; ss += (v[j].x * v[j].x + v[j].y * v[j].y) + (v[j].z * v[j].z + v[j].w * v[j].w); }
            const float rstd = __builtin_amdgcn_rsqf(wave_sum(ss) * (1.f / DM) + EPS);
            u32x2* o8 = (u32x2*)(hb + (size_t)m * DM) + lane;
#pragma unroll
            for (int j = 0; j < 8; ++j) { const f32x4 g = ((const f32x4*)g2)[64 * j + lane]; v[j] = v[j] * rstd * g;
                u32x2 o; o.x = pk2(v[j].x, v[j].y); o.y = pk2(v[j].z, v[j].w); o8[64 * j] = o; }
            float L[36];
            const float* rwl = rw; asm volatile("" : "+s"(rwl));
#pragma unroll
            for (int c = 0; c < 36; ++c) { const f32x4* wc = (const f32x4*)(rwl + (size_t)c * DM) + lane; float a = 0.f;
#pragma unroll
                for (int j = 0; j < 8; ++j) { const f32x4 w = wc[64 * j]; a += (v[j].x * w.x + v[j].y * w.y) + (v[j].z * w.z + v[j].w * w.w); }
                L[c] = wave_sum(a); if (c & 1) asm volatile("" ::: "memory"); }
            float gl[4]; float gmax = -INFINITY; int gsel = 0;
#pragma unroll
            for (int i = 0; i < 4; ++i) { gl[i] = L[i] + brg[i]; if (gl[i] > gmax) { gmax = gl[i]; gsel = i; } }
            float gsum = 0.f;
#pragma unroll
            for (int i = 0; i < 4; ++i) gsum += __expf(gl[i] - gmax);
            const float gp = 1.0f / gsum;
            float el[8];
#pragma unroll
            for (int j = 0; j < 8; ++j) { const float e0 = L[4 + j] + bre[j], e1 = L[12 + j] + bre[8 + j], e2 = L[20 + j] + bre[16 + j], e3 = L[28 + j] + bre[24 + j];
                el[j] = gsel == 0 ? e0 : (gsel == 1 ? e1 : (gsel == 2 ? e2 : e3)); }
            float m0 = -INFINITY; int i0 = 0;
#pragma unroll
            for (int j = 0; j < 8; ++j) if (el[j] > m0) { m0 = el[j]; i0 = j; }
            float m1 = -INFINITY; int i1 = 0;
#pragma unroll
            for (int j = 0; j < 8; ++j) if (j != i0 && el[j] > m1) { m1 = el[j]; i1 = j; }
            const float r = __expf(m1 - m0), w0 = gp / (1.0f + r), w1 = gp * r / (1.0f + r);
            if (lane == 0) { const unsigned e0 = (unsigned)(gsel * 8 + i0), e1 = (unsigned)(gsel * 8 + i1);
                const unsigned p0 = atomicAdd((unsigned*)(lcnt + e0), 1u), p1 = atomicAdd((unsigned*)(lcnt + e1), 1u);
                LAS unsigned* q = rt + rl * 6; q[0] = e0; q[1] = p0; q[2] = e1; q[3] = p1; q[4] = __builtin_bit_cast(unsigned, w0); q[5] = __builtin_bit_cast(unsigned, w1); }
        }
        __syncthreads();
        if (tid < 32) lbase[tid] = __hip_atomic_fetch_add(gcnt + tid, lcnt[tid], __ATOMIC_RELAXED, __HIP_MEMORY_SCOPE_AGENT);
        __syncthreads();
        if (tid < 64) { const int m = bt * 64 + tid; const LAS unsigned* q = rt + tid * 6;
            const unsigned e0 = q[0], p0 = lbase[e0] + q[1], e1 = q[2], p1 = lbase[e1] + q[3];
            toklist[(size_t)e0 * TOKCAP + p0] = m; toklist[(size_t)e1 * TOKCAP + p1] = m;
            u32x4 a; a.x = e0; a.y = p0; a.z = e1; a.w = p1; *(u32x4*)(route + (size_t)m * 8) = a;
            u32x2 b; b.x = q[4]; b.y = q[5]; *(u32x2*)(route + (size_t)m * 8 + 4) = b; }
    }
}

constexpr int PPL = 9, NPH = 2 + PPL * DEPTH;
__global__ void __launch_bounds__(NWAVES * 64, 2) hybrid_fwd(Params p) {
    extern __shared__ __attribute__((aligned(16))) unsigned char lds_raw[];
    Frame F;
    F.lds = (LAS unsigned char*)lds_raw;
    F.G = gridDim.x; { const int bx = blockIdx.x; F.vcu = (F.G % 8 == 0) ? (bx % 8) * (F.G / 8) + bx / 8 : bx; }
    for (int u = threadIdx.x; u < (LDS_BYTES - LDSCTL_OFF) / 4; u += NWAVES * 64) ((LAS unsigned*)(F.lds + LDSCTL_OFF))[u] = 0u;
    __syncthreads();
    const int lo = p.ph_lo, hi = p.ph_hi;
    XcdBarrier bar; bar.bar = (unsigned*)(p.ws + WS_CTL) + CW_BAR; bar.x = 0; bar.st = nullptr;
    if (hi - lo > 1) bar = xcd_barrier_post((unsigned*)(p.ws + WS_CTL) + CW_BAR, (volatile LAS unsigned*)(F.lds + LDSCTL_OFF + 32));
#define IN(k) (lo <= (k) && (k) < hi)
#define SEAM(k) do { if (IN(k) && IN((k) + 1)) xcd_barrier(bar); } while (0)

    if (IN(0)) { phase_w(F); }
    SEAM(0);
    for (int l = 0; l < DEPTH; ++l) {
        const int pb = 1 + PPL * l;
        if (IN(pb + 0)) {
            const KArgs P = kargs();
            if (l == 0) phase_norm1<0>(F, l, P->in[I_X], nullptr); else phase_norm1<1>(F, l, (const float*)(P->ws + WS_X1), P->out);
        }
        SEAM(pb + 0);
        if (IN(pb + 1)) {
            const KArgs P = kargs(); unsigned char* const ws = P->ws;
            pg8::SchedStatic S; S.o.init(T, NZ, F.G, (int)blockIdx.x); S.Bt = (const char*)(ws + WS_WIN + l * SZ_WIN); S.tstepB = (size_t)256 * DM * 2;
            pg8::EpiBf16 E{(bf16_t*)(ws + WS_Z), NZ};
            pg8::gemm_phase(F.lds, (const char*)(ws + WS_HB), DM, S, E);
        }
        SEAM(pb + 1);
#ifdef NAIVE_MIX
        if (IN(pb + 2)) { phase_prep(F, l); }
        SEAM(pb + 2);
        if (IN(pb + 3)) { phase_mix_naive(F, l); }
        SEAM(pb + 3);
        SEAM(pb + 4);
#else
        if (IN(pb + 2)) { phase_c1(F, l); }
        SEAM(pb + 2);
        if (IN(pb + 3)) { phase_c2(F, l); }
        SEAM(pb + 3);
        if (IN(pb + 4)) { phase_c3(F, l); }
        SEAM(pb + 4);
#endif
        if (IN(pb + 5)) {
            const KArgs P = kargs(); unsigned char* const ws = P->ws;
            const float* xl = l == 0 ? P->in[I_X] : (const float*)P->out;
            pg8::SchedStatic S; S.o.init(T, DM, F.G, (int)blockIdx.x); S.Bt = (const char*)(ws + WS_WOUT + l * SZ_WOUT); S.tstepB = (size_t)256 * DM * 2;
            pg8::EpiResF32 E{xl, (float*)(ws + WS_X1), DM};
            pg8::gemm_phase(F.lds, (const char*)(ws + WS_Y), DM, S, E);
        }
        SEAM(pb + 5);
        if (IN(pb + 6)) { phase_router(F, l); }
        SEAM(pb + 6);
        if (IN(pb + 7)) {
            const MoeTab mt = moe_tab(F, l);
            const KArgs P = kargs(); unsigned char* const ws = P->ws;
            pg8::SchedMoe<true> S; S.G = F.G; S.c = (int)blockIdx.x; S.MT = mt.tstart[NE]; S.tstart = mt.tstart; S.cnt = mt.cnt; S.toklist = (const int*)(ws + WS_TOK);
            S.Wt = (const char*)(ws + WS_WGU + l * SZ_WGU); S.estride = (size_t)2048 * DM * 2; S.tstepB = (size_t)256 * DM * 2;
            pg8::EpiGateUp E{(bf16_t*)(ws + WS_HH)};
            pg8::gemm_phase(F.lds, (const char*)(ws + WS_HB), DM, S, E);
        }
        SEAM(pb + 7);
        if (IN(pb + 8)) {
            const MoeTab mt = moe_tab(F, l);
            const KArgs P = kargs(); unsigned char* const ws = P->ws;
            pg8::SchedMoe<false> S; S.G = F.G; S.c = (int)blockIdx.x; S.MT = mt.tstart[NE]; S.tstart = mt.tstart; S.cnt = mt.cnt; S.toklist = nullptr;
            S.Wt = (const char*)(ws + WS_WD + l * SZ_WD); S.estride = (size_t)DM * DFF * 2; S.tstepB = (size_t)256 * DFF * 2;
            pg8::EpiBf16 E{(bf16_t*)(ws + WS_Z), DM};
            pg8::gemm_phase(F.lds, (const char*)(ws + WS_HH), DFF, S, E);
        }
        SEAM(pb + 8);
    }
    if (IN(NPH - 1)) { const KArgs P = kargs(); phase_norm1<2>(F, DEPTH, (const float*)(P->ws + WS_X1), P->out); }
#undef IN
#undef SEAM
}

extern "C" void kernel_launch(void* const* d_in, const int* in_sizes, int n_in, void* d_out, int out_size, void* d_ws, size_t ws_size, hipStream_t stream) {
    static int grid = 0;
    if (grid == 0) {
        if (n_in != 20 || out_size != T * DM || ws_size < WS_END) { fprintf(stderr, "kernel_launch: unexpected shapes (n_in %d out %d ws %zu need %zu)\n", n_in, out_size, ws_size, (size_t)WS_END); grid = -1; return; }
        int dev = 0, cus = 0, per_cu = 0;
        if (hipGetDevice(&dev) != hipSuccess || hipDeviceGetAttribute(&cus, hipDeviceAttributeMultiprocessorCount, dev) != hipSuccess) { grid = -1; return; }
        if (hipFuncSetAttribute((const void*)hybrid_fwd, hipFuncAttributeMaxDynamicSharedMemorySize, LDS_BYTES) != hipSuccess) { fprintf(stderr, "kernel_launch: hipFuncSetAttribute failed\n"); grid = -1; return; }
        if (hipOccupancyMaxActiveBlocksPerMultiprocessor(&per_cu, (const void*)hybrid_fwd, NWAVES * 64, LDS_BYTES) != hipSuccess || per_cu < 1)
            fprintf(stderr, "kernel_launch: note: occupancy query reports %d workgroups per CU\n", per_cu);
        (void)hipGetLastError();
        grid = cus;
    }
    if (grid < 0) return;
    if (hipMemsetAsync((char*)d_ws + WS_CTL, 0, CTL_ZERO_BYTES, stream) != hipSuccess) return;
    Params a{};
    for (int i = 0; i < 20; ++i) a.in[i] = (const float*)d_in[i];
    a.out = (float*)d_out; a.ws = (unsigned char*)d_ws;
#if MK_PER_PHASE
    for (int ph = 0; ph < NPH; ++ph) { a.ph_lo = ph; a.ph_hi = ph + 1; hipLaunchKernelGGL(hybrid_fwd, dim3(grid), dim3(NWAVES * 64), LDS_BYTES, stream, a); }
#else
    a.ph_lo = 0; a.ph_hi = NPH;
    hipLaunchKernelGGL(hybrid_fwd, dim3(grid), dim3(NWAVES * 64), LDS_BYTES, stream, a);
#endif
    const hipError_t le = hipPeekAtLastError();
    if (le != hipSuccess) fprintf(stderr, "kernel_launch: launch failed: %s\n", hipGetErrorName(le));
}
```

```cpp
#include <hip/hip_runtime.h>
#include <cstdio>
#include <cstdint>

#ifndef MK_PER_PHASE
#define MK_PER_PHASE 0
#endif

#define GAS __attribute__((address_space(1)))
#define LAS __attribute__((address_space(3)))
typedef unsigned short bf16_t;
typedef short bf16x8 __attribute__((ext_vector_type(8)));
typedef float f32x4 __attribute__((ext_vector_type(4)));
typedef float f32x2 __attribute__((ext_vector_type(2)));
typedef unsigned u32x4 __attribute__((ext_vector_type(4)));
typedef unsigned u32x2 __attribute__((ext_vector_type(2)));
#define LDS_WAIT() asm volatile("s_waitcnt lgkmcnt(0)" ::: "memory")
#define VM_WAIT() asm volatile("s_waitcnt vmcnt(0)" ::: "memory")

constexpr int DM = 2048, NBATCH = 4, SEQ = 4096, T = NBATCH * SEQ, DEPTH = 2;
constexpr int HD = 128, NH = 4, NIN = 7180, NZ = 7168;
constexpr int NE = 32, DFF = 1024, TOKCAP = T;
constexpr float EPS = 1e-6f;
constexpr int ZQ_R = 0, ZK_R = 512, ZV_R = 1024, ZG_R = 1536, ZQ_F = 2048, ZK_F = 2560, ZV_F = 3072;
constexpr int ZQ_M = 3584, ZK_M = 4096, ZV_M = 4608, ZO_M = 5120, ZH_C = 5632, ZB_C = 6144, ZC_C = 6656;
constexpr int MAXMT = T * 2 / 256 + NE;

constexpr size_t MiB = 1u << 20;
constexpr size_t WS_CTL = 0, CTL_ZERO_BYTES = 1 * MiB;
constexpr size_t SZ_WIN = (size_t)NZ * DM * 2, SZ_WOUT = (size_t)DM * DM * 2, SZ_WGU = (size_t)NE * 2048 * DM * 2, SZ_WD = (size_t)NE * DM * DFF * 2;
constexpr size_t WS_WIN = 1 * MiB;
constexpr size_t WS_WOUT = WS_WIN + DEPTH * SZ_WIN;
constexpr size_t WS_WGU = WS_WOUT + DEPTH * SZ_WOUT;
constexpr size_t WS_WD = WS_WGU + DEPTH * SZ_WGU;
constexpr size_t WS_GW = WS_WD + DEPTH * SZ_WD;
constexpr size_t WS_RW = WS_GW + DEPTH * 12 * DM * 4;
constexpr size_t WS_HB = WS_RW + DEPTH * 36 * DM * 4;
constexpr size_t WS_Z = WS_HB + (size_t)T * DM * 2;
constexpr size_t WS_GATES = WS_Z + (size_t)T * NZ * 2;
constexpr size_t WS_PREF = WS_GATES + (size_t)T * 12 * 4;
constexpr size_t WS_Y = WS_PREF + 4 * 16 * SEQ * 4;
constexpr size_t WS_X1 = WS_Y + (size_t)T * DM * 2;
constexpr size_t WS_HH = WS_X1 + (size_t)T * DM * 4;
constexpr size_t WS_ROUTE = WS_HH + (size_t)MAXMT * 256 * DFF * 2;
constexpr size_t WS_TOK = WS_ROUTE + (size_t)T * 32;
constexpr size_t WS_STATE = WS_TOK + (size_t)NE * TOKCAP * 4;
constexpr size_t WS_RWB = WS_STATE + 72 * MiB;
constexpr size_t WS_END = WS_STATE + 80 * MiB;
static_assert((size_t)MAXMT * 256 * DM * 2 <= (size_t)T * NZ * 2, "ys overlays z");
constexpr int CW_BAR = 4096;
constexpr int CW_CNT = 16384;

constexpr int RING_BYTES = 131072;
constexpr int LDSCTL_OFF = RING_BYTES;
constexpr int LDS_BYTES = 147456;
constexpr int NWAVES = 8;

__device__ __forceinline__ unsigned f2bf(float f) { unsigned u = __builtin_bit_cast(unsigned, f); return (u + 0x7fffu + ((u >> 16) & 1u)) >> 16; }
__device__ __forceinline__ unsigned pk2(float lo, float hi) { return f2bf(lo) | (f2bf(hi) << 16); }
__device__ __forceinline__ float bflo(unsigned w) { return __builtin_bit_cast(float, w << 16); }
__device__ __forceinline__ float bfhi(unsigned w) { return __builtin_bit_cast(float, w & 0xffff0000u); }
__device__ __forceinline__ float bf2f(bf16_t b) { return __builtin_bit_cast(float, (unsigned)b << 16); }
__device__ __forceinline__ float wave_sum(float v) {
#pragma unroll
    for (int o = 1; o < 64; o <<= 1) v += __shfl_xor(v, o);
    return v;
}
__device__ __forceinline__ float fast_exp(float x) { return __builtin_amdgcn_exp2f(x * 1.4426950408889634f); }
__device__ __forceinline__ float sigmoidf_(float x) { return __builtin_amdgcn_rcpf(1.0f + fast_exp(-x)); }
__device__ __forceinline__ float siluf_(float x) { return x * sigmoidf_(x); }
__device__ __forceinline__ float log_sigmoidf_(float x) { return fminf(x, 0.0f) - log1pf(__expf(-fabsf(x))); }

namespace pg8 {
constexpr int BM = 256, BK = 64, HALF = 128, HTB = HALF * BK * 2, STAGE_BYTES = 8 * HTB, NXCD = 8, WGM = 8;
__host__ __device__ __forceinline__ int lds_byte(int r, int c) { const int st = (r >> 4) * 2 + (c >> 5), rr = r & 15, cc = c & 31, ob = rr * 64 + cc * 2; return st * 1024 + (ob ^ (((ob >> 9) & 1) << 5)); }
__host__ __device__ __forceinline__ void stage_rc(int b, int& R, int& C) { const int st = b / 1024, sb = b % 1024, swz = sb ^ (((sb >> 9) & 1) << 5); R = (st >> 1) * 16 + swz / 64; C = (st & 1) * 32 + (swz % 64) / 2; }
__host__ __device__ __forceinline__ int perm32(int rho) { const int n = rho >> 4, i = rho & 15; return 8 * (i >> 2) + 4 * n + (i & 3); }

struct Unit { int pm, pn, e; };

struct StaticOrder {
    int nM, nN, nwg, G, c;
    __host__ __device__ void init(int M, int N, int G_, int c_) { nM = M / BM; nN = N / BM; nwg = nM * nN; G = G_; c = c_; }
    __host__ __device__ bool next(int i, Unit& u) const {
        const long L = (long)i * G + c; if (L >= nwg) return false;
        int wgid = (int)L; { const int q = nwg / NXCD, r = nwg % NXCD, xcd = wgid % NXCD, off = wgid / NXCD; wgid = (xcd < r ? xcd * (q + 1) : r * (q + 1) + (xcd - r) * q) + off; }
        const int nig = WGM * nN, gid = wgid / nig, fm = gid * WGM, gsz = (nM - fm) < WGM ? (nM - fm) : WGM;
        u.pm = fm + ((wgid % nig) % gsz); u.pn = (wgid % nig) / gsz; u.e = 0; return true;
    }
};
struct SchedStatic {
    StaticOrder o; const char* Bt; size_t tstepB;
    __device__ __forceinline__ bool next(int i, Unit& u) const { return o.next(i, u); }
    __device__ __forceinline__ int arow(const Unit& u, int r) const { return u.pm * BM + r; }
    __device__ __forceinline__ const char* bptr(const Unit& u) const { return Bt + (size_t)u.pn * tstepB; }
};
template <bool GATHER> struct SchedMoe {
    int G, c, MT; const LAS int* tstart; const LAS int* cnt; const int* toklist; const char* Wt; size_t estride, tstepB;
    __device__ __forceinline__ bool next(int i, Unit& u) const {
        const int L = i * G + c; if (L >= MT * 8) return false;
        u.pm = L >> 3; u.pn = L & 7; int e = 0;
        for (; e < NE - 1; ++e) if (u.pm < tstart[e + 1]) break;
        u.e = e; return true;
    }
    __device__ __forceinline__ int arow(const Unit& u, int r) const {
        if (!GATHER) return u.pm * BM + r;
        const int idx = (u.pm - tstart[u.e]) * BM + r;
        return idx < cnt[u.e] ? toklist[(size_t)u.e * TOKCAP + idx] : 0;
    }
    __device__ __forceinline__ const char* bptr(const Unit& u) const { return Wt + (size_t)u.e * estride + (size_t)u.pn * tstepB; }
};

struct EpiBf16 {
    static constexpr bool PERM = true;
    bf16_t* O; int ldc;
    __device__ __forceinline__ void operator()(const f32x4 (&acc)[2][2][4][2], const Unit& u, int wr, int wc, int fr, int fq) const {
        const int row0 = u.pm * BM + wr * 64 + fr, col0 = u.pn * BM + wc * 32 + 8 * fq;
#pragma unroll
        for (int ai = 0; ai < 2; ++ai)
#pragma unroll
            for (int m = 0; m < 4; ++m) { bf16_t* rowp = O + (size_t)(row0 + ai * HALF + m * 16) * ldc + col0;
#pragma unroll
                for (int bj = 0; bj < 2; ++bj) { const f32x4 v0 = acc[ai][bj][m][0], v1 = acc[ai][bj][m][1];
                    u32x4 w; w.x = pk2(v0[0], v0[1]); w.y = pk2(v0[2], v0[3]); w.z = pk2(v1[0], v1[1]); w.w = pk2(v1[2], v1[3]);
                    *(u32x4*)(rowp + bj * HALF) = w; } }
    }
};
struct EpiResF32 {
    static constexpr bool PERM = false;
    const float* R; float* C; int ldc;
    __device__ __forceinline__ void operator()(const f32x4 (&acc)[2][2][4][2], const Unit& u, int wr, int wc, int fr, int fq) const {
        const int row0 = u.pm * BM + wr * 64 + fr, col0 = u.pn * BM + wc * 32 + 4 * fq;
#pragma unroll
        for (int ai = 0; ai < 2; ++ai)
#pragma unroll
            for (int m = 0; m < 4; ++m) { const size_t off = (size_t)(row0 + ai * HALF + m * 16) * ldc + col0;
#pragma unroll
                for (int bj = 0; bj < 2; ++bj)
#pragma unroll
                    for (int n = 0; n < 2; ++n) { const f32x4 r = *(const f32x4*)(R + off + bj * HALF + n * 16); *(f32x4*)(C + off + bj * HALF + n * 16) = r + acc[ai][bj][m][n]; }
                asm volatile("" ::: "memory"); }
    }
};
struct EpiGateUp {
    static constexpr bool PERM = true;
    bf16_t* H;
    __device__ __forceinline__ void operator()(const f32x4 (&acc)[2][2][4][2], const Unit& u, int wr, int wc, int fr, int fq) const {
        const int row0 = u.pm * BM + wr * 64 + fr, col0 = u.pn * HALF + wc * 32 + 8 * fq;
#pragma unroll
        for (int ai = 0; ai < 2; ++ai)
#pragma unroll
            for (int m = 0; m < 4; ++m) { bf16_t* rowp = H + (size_t)(row0 + ai * HALF + m * 16) * DFF + col0;
                float o[8];
#pragma unroll
                for (int n = 0; n < 2; ++n)
#pragma unroll
                    for (int j = 0; j < 4; ++j) { const float g = acc[ai][0][m][n][j], up = acc[ai][1][m][n][j]; o[n * 4 + j] = siluf_(g) * up; }
                u32x4 w; w.x = pk2(o[0], o[1]); w.y = pk2(o[2], o[3]); w.z = pk2(o[4], o[5]); w.w = pk2(o[6], o[7]);
                *(u32x4*)rowp = w; }
    }
};

template <class Epi, class Sched>
__device__ __forceinline__ void gemm_phase(LAS unsigned char* lds, const char* Abase, const int K, const Sched& S, const Epi& E) {
    int tid = threadIdx.x; asm volatile("" : "+v"(tid));
    const int wid = __builtin_amdgcn_readfirstlane(tid >> 6), lane = tid & 63, wr = wid >> 2, wc = wid & 3, fr = lane & 15, fq = lane >> 4;
    const int nt = K / BK;
    int Ri[2]; unsigned Ci[2], voffB[2];
#pragma unroll
    for (int i = 0; i < 2; ++i) { int R, C; stage_rc(tid * 16 + i * 8192, R, C); const int Rb = Epi::PERM ? ((R & ~31) + perm32(R & 31)) : R;
        Ri[i] = R; Ci[i] = (unsigned)C * 2u; voffB[i] = (unsigned)(Rb * K + C) * 2u; }
    const unsigned rowB = (unsigned)K * 2u;
    const size_t kstep = (size_t)(BK * 2);
    const size_t hstep = (size_t)HALF * K * 2;
    const unsigned ldsw = (unsigned)wid * 1024u;
    const int aoff = lds_byte(wr * 64 + fr, fq * 8), boff = lds_byte(wc * 32 + fr, fq * 8);
#define PG8_SA(b, h) (((b) * 2 + (h)) * HTB)
#define PG8_SB(b, h) ((4 + (b) * 2 + (h)) * HTB)
#define PG8_STAGE(bufoff, gbase, voff) do { _Pragma("unroll") for (int _i = 0; _i < 2; ++_i) \
        __builtin_amdgcn_global_load_lds((const unsigned*)((const char*)(gbase) + (voff)[_i]), (LAS unsigned*)(lds + (bufoff) + ldsw + _i * 8192), 16, 0, 0); } while (0)
#define PG8_LDA(dst, b, h) do { _Pragma("unroll") for (int m = 0; m < 4; ++m) _Pragma("unroll") for (int k = 0; k < 2; ++k) dst[m][k] = *(const LAS bf16x8*)(lds + PG8_SA(b, h) + aoff + m * 2048 + k * 1024); } while (0)
#define PG8_LDB(dst, b, h) do { _Pragma("unroll") for (int n = 0; n < 2; ++n) _Pragma("unroll") for (int k = 0; k < 2; ++k) dst[n][k] = *(const LAS bf16x8*)(lds + PG8_SB(b, h) + boff + n * 2048 + k * 1024); } while (0)
#define PG8_MMA(ai, bj, At, Bt) do { __builtin_amdgcn_s_setprio(1); _Pragma("unroll") for (int m = 0; m < 4; ++m) _Pragma("unroll") for (int n = 0; n < 2; ++n) _Pragma("unroll") for (int k = 0; k < 2; ++k) \
        acc[ai][bj][m][n] = __builtin_amdgcn_mfma_f32_16x16x32_bf16(Bt[n][k], At[m][k], acc[ai][bj][m][n], 0, 0, 0); __builtin_amdgcn_s_setprio(0); } while (0)
#define PG8_WAIT_V(n) asm volatile("s_waitcnt vmcnt(" #n ")" ::: "memory")
#define PG8_WAIT_L(n) asm volatile("s_waitcnt lgkmcnt(" #n ")" ::: "memory")
#define PG8_BAR __builtin_amdgcn_s_barrier()
#define PG8_SCHED __builtin_amdgcn_sched_barrier(0)
#define PG8_AOFF(dst, u) do { _Pragma("unroll") for (int _h = 0; _h < 2; ++_h) _Pragma("unroll") for (int _i = 0; _i < 2; ++_i) \
        dst[_h][_i] = (unsigned)S.arow(u, _h * HALF + Ri[_i]) * rowB + Ci[_i]; } while (0)
    Unit cur, nxt; int ui = 0;
    if (!S.next(0, cur)) return;
    f32x4 acc[2][2][4][2];
#pragma unroll
    for (int a = 0; a < 2; ++a)
#pragma unroll
        for (int b = 0; b < 2; ++b)
#pragma unroll
            for (int m = 0; m < 4; ++m)
#pragma unroll
                for (int n = 0; n < 2; ++n) acc[a][b][m][n] = (f32x4){0.f, 0.f, 0.f, 0.f};
    bf16x8 At[4][2], B0[2][2], B1[2][2];
    unsigned ac[2][2], an[2][2];
    PG8_AOFF(ac, cur);
    const char* cB = S.bptr(cur);
    PG8_STAGE(PG8_SB(0, 0), cB, voffB); PG8_STAGE(PG8_SB(0, 1), cB + hstep, voffB); PG8_STAGE(PG8_SA(0, 0), Abase, ac[0]); PG8_STAGE(PG8_SA(0, 1), Abase, ac[1]);
    if (wr == 1) PG8_BAR;
    PG8_WAIT_V(2); PG8_BAR;
    PG8_STAGE(PG8_SB(1, 0), cB + kstep, voffB); PG8_STAGE(PG8_SA(1, 0), Abase + kstep, ac[0]); PG8_STAGE(PG8_SB(1, 1), cB + hstep + kstep, voffB);
    PG8_WAIT_V(6); PG8_BAR;
    for (;;) {
        const bool has_next = S.next(ui + 1, nxt);
        const char* nB = cB;
        if (has_next) { PG8_AOFF(an, nxt); nB = S.bptr(nxt); }
        else {
#pragma unroll
            for (int h = 0; h < 2; ++h)
#pragma unroll
                for (int i = 0; i < 2; ++i) an[h][i] = ac[h][i]; }
        for (int t = 0; t < nt; t += 2) {
            const bool last = (t == nt - 2);
            const char* a1 = Abase + (size_t)(t + 1) * kstep;
            const char* a2 = last ? Abase : Abase + (size_t)(t + 2) * kstep; const char* b2 = last ? nB : cB + (size_t)(t + 2) * kstep;
            const char* a3 = a2 + kstep; const char* b3 = b2 + kstep;
            unsigned a2o[2][2];
#pragma unroll
            for (int h = 0; h < 2; ++h)
#pragma unroll
                for (int i = 0; i < 2; ++i) a2o[h][i] = last ? an[h][i] : ac[h][i];
            PG8_LDB(B0, 0, 0); PG8_LDB(B1, 0, 1); PG8_SCHED; PG8_LDA(At, 0, 0); PG8_STAGE(PG8_SA(1, 1), a1, ac[1]);
            PG8_WAIT_V(8); PG8_WAIT_L(0); PG8_BAR; PG8_MMA(0, 0, At, B0); PG8_MMA(0, 1, At, B1); PG8_BAR; PG8_SCHED;
            PG8_LDA(At, 0, 1); PG8_STAGE(PG8_SB(0, 0), b2, voffB); PG8_STAGE(PG8_SB(0, 1), b2 + hstep, voffB); PG8_STAGE(PG8_SA(0, 0), a2, a2o[0]);
            PG8_WAIT_V(8); PG8_WAIT_L(0); PG8_BAR; PG8_MMA(1, 0, At, B0); PG8_MMA(1, 1, At, B1); PG8_BAR; PG8_SCHED;
            PG8_LDB(B0, 1, 0); PG8_LDB(B1, 1, 1); PG8_SCHED; PG8_LDA(At, 1, 0); PG8_STAGE(PG8_SA(0, 1), a2, a2o[1]);
            PG8_WAIT_V(8); PG8_WAIT_L(0); PG8_BAR; PG8_MMA(0, 0, At, B0); PG8_MMA(0, 1, At, B1); PG8_BAR; PG8_SCHED;
            PG8_LDA(At, 1, 1); PG8_STAGE(PG8_SB(1, 0), b3, voffB); PG8_STAGE(PG8_SB(1, 1), b3 + hstep, voffB); PG8_STAGE(PG8_SA(1, 0), a3, a2o[0]);
            PG8_WAIT_V(8); PG8_WAIT_L(0); PG8_BAR; PG8_MMA(1, 0, At, B0); PG8_MMA(1, 1, At, B1); PG8_BAR; PG8_SCHED;
        }
        if (wr == 0) PG8_BAR;
        E(acc, cur, wr, wc, fr, fq);
        if (!has_next) break;
#pragma unroll
        for (int a = 0; a < 2; ++a)
#pragma unroll
            for (int b = 0; b < 2; ++b)
#pragma unroll
                for (int m = 0; m < 4; ++m)
#pragma unroll
                    for (int n = 0; n < 2; ++n) acc[a][b][m][n] = (f32x4){0.f, 0.f, 0.f, 0.f};
        cur = nxt; cB = nB; ++ui;
#pragma unroll
        for (int h = 0; h < 2; ++h)
#pragma unroll
            for (int i = 0; i < 2; ++i) ac[h][i] = an[h][i];
        if (wr == 1) PG8_BAR;
    }
    PG8_WAIT_V(0);
    PG8_BAR;
#undef PG8_SA
#undef PG8_SB
#undef PG8_STAGE
#undef PG8_LDA
#undef PG8_LDB
#undef PG8_MMA
#undef PG8_WAIT_V
#undef PG8_WAIT_L
#undef PG8_BAR
#undef PG8_SCHED
#undef PG8_AOFF
}
}

#define XB_TMO      128
#define XB_XCNT(j)  (256  + 64 * (j))
#define XB_XSUB(j)  (1280 + 64 * (j))
#define XB_XGEN(j)  (2304 + 64 * (j))
#define XB_TOP      3328
#define XB_TOPGEN   3392
#define XCD_BAR_WORDS 3456
#define XB_SPIN_CAP (1u << 18)
__device__ __forceinline__ unsigned xb_ld(unsigned* p)              { return __hip_atomic_load(p, __ATOMIC_RELAXED, __HIP_MEMORY_SCOPE_AGENT); }
__device__ __forceinline__ unsigned xb_add(unsigned* p, unsigned v) { return __hip_atomic_fetch_add(p, v, __ATOMIC_RELAXED, __HIP_MEMORY_SCOPE_AGENT); }
__device__ __forceinline__ unsigned xb_xcc_id() { return (unsigned)__builtin_amdgcn_s_getreg((3 << 11) | 20) & 0xFu; }
#define XB_SPIN(cond, bar) do { unsigned _sp = 0; while (cond) { __builtin_amdgcn_s_sleep(1); \
    if ((++_sp & 255u) == 0u) { if (xb_ld(&(bar)[XB_TMO])) break; if (_sp > XB_SPIN_CAP) { atomicAdd(&(bar)[XB_TMO], 1u); break; } } } } while (0)
struct XcdBarrier { unsigned* bar; unsigned x; volatile LAS unsigned* st; };
__device__ __forceinline__ XcdBarrier xcd_barrier_post(unsigned* bar, volatile LAS unsigned* st) {
    XcdBarrier b; b.bar = bar; b.x = xb_xcc_id(); b.st = st;
    if (threadIdx.x == 0) (void)xb_add(&bar[XB_XCNT(b.x)], 1u);
    return b;
}
__device__ __forceinline__ void xcd_barrier_complete(unsigned* bar, unsigned x, unsigned& nloc, unsigned& nx) {
    const unsigned G = gridDim.x * gridDim.y * gridDim.z;
    unsigned sum, cnt, mine, sp = 0u;
    for (;;) {
        sum = 0u; cnt = 0u; mine = 0u;
#pragma unroll
        for (unsigned j = 0; j < 16; ++j) { const unsigned c = xb_ld(&bar[XB_XCNT(j)]); sum += c; cnt += (c > 0u) ? 1u : 0u; mine = (j == x) ? c : mine; }
        if (sum == G) break;
        __builtin_amdgcn_s_sleep(1);
        if ((++sp & 255u) == 0u) { if (xb_ld(&bar[XB_TMO])) break; if (sp > XB_SPIN_CAP) { atomicAdd(&bar[XB_TMO], 1u); break; } }
    }
    nloc = mine > 0u ? mine : 1u; nx = cnt > 0u ? cnt : 1u;
}
__device__ __forceinline__ void xcd_barrier(const XcdBarrier& b) {
    asm volatile("s_waitcnt vmcnt(0)" ::: "memory");
    __syncthreads();
    if (threadIdx.x == 0) {
        unsigned* bar = b.bar;
        __builtin_amdgcn_s_waitcnt(0);
        unsigned nloc = b.st[0], nx = b.st[1];
        if (nloc == 0u) { xcd_barrier_complete(bar, b.x, nloc, nx); b.st[0] = nloc; b.st[1] = nx; }
        const unsigned old = xb_add(&bar[XB_XSUB(b.x)], 1u);
        const unsigned gen = old / nloc;
        if (old + 1u == (gen + 1u) * nloc) {
            __builtin_amdgcn_fence(__ATOMIC_RELEASE, "agent");
            asm volatile("s_waitcnt vmcnt(0)" ::: "memory");
            const unsigned og = xb_add(&bar[XB_TOP], 1u);
            const unsigned tg = og / nx;
            if (og + 1u == (tg + 1u) * nx) xb_add(&bar[XB_TOPGEN], 1u);
            else XB_SPIN(xb_ld(&bar[XB_TOPGEN]) == tg, bar);
            __builtin_amdgcn_fence(__ATOMIC_ACQUIRE, "agent");
            xb_add(&bar[XB_XGEN(b.x)], 1u);
            asm volatile("s_waitcnt vmcnt(0)" ::: "memory");
        } else {
            XB_SPIN(xb_ld(&bar[XB_XGEN(b.x)]) == gen, bar);
            __builtin_amdgcn_fence(__ATOMIC_ACQUIRE, "agent");
            asm volatile("s_waitcnt vmcnt(0)" ::: "memory");
        }
    }
    __syncthreads();
}

struct Params { const float* in[20]; float* out; unsigned char* ws; int ph_lo, ph_hi; };
struct Frame { LAS unsigned char* lds; int vcu, G; };
typedef const __attribute__((address_space(4))) Params* KArgs;
__device__ __forceinline__ KArgs kargs() { KArgs q = (KArgs)__builtin_amdgcn_kernarg_segment_ptr(); asm volatile("" : "+s"(q)); return q; }
#define PHASE_BEGIN() const KArgs P = kargs(); unsigned char* const ws = P->ws; int tid = threadIdx.x; asm volatile("" : "+v"(tid)); \
    const int lane = tid & 63; const int wave = __builtin_amdgcn_readfirstlane(tid >> 6); (void)lane; (void)wave; (void)ws
enum { I_X = 0, I_POS, I_N1G, I_WIN, I_FFB, I_FQN, I_FKN, I_MIB, I_MFB, I_CONVW, I_HNG, I_WOUT, I_N2G, I_WRG, I_BRG, I_WRE, I_BRE, I_WG, I_WU, I_WD };

__device__ __forceinline__ void transpose_item(const float* W, int K, int Nsrc, bf16_t* WT, int src_n0, int dst_r0, int k0, LAS float* scr, int lane) {
#pragma unroll 8
    for (int i = 0; i < 32; ++i) { const int kk = 2 * i + (lane >> 5); scr[kk * 33 + (lane & 31)] = W[(size_t)(k0 + kk) * Nsrc + src_n0 + (lane & 31)]; }
    LDS_WAIT();
    const int c = lane & 7;
#pragma unroll
    for (int j = 0; j < 4; ++j) { const int n = (lane >> 3) + 8 * j; const LAS float* s = scr + (8 * c) * 33 + n;
        u32x4 o; o.x = pk2(s[0 * 33], s[1 * 33]); o.y = pk2(s[2 * 33], s[3 * 33]); o.z = pk2(s[4 * 33], s[5 * 33]); o.w = pk2(s[6 * 33], s[7 * 33]);
        *(u32x4*)(WT + (size_t)(dst_r0 + n) * K + k0 + 8 * c) = o; }
    LDS_WAIT();
}
__device__ __forceinline__ void phase_w(Frame& F) {
    PHASE_BEGIN();
    LAS float* scr = (LAS float*)(F.lds + wave * 16384);
    const int gw = F.vcu * NWAVES + wave, NGW = F.G * NWAVES;
    constexpr int I_IN = 32 * 224, I_OUT = 32 * 64, I_EX = NE * 1024, PER_L = I_IN + I_OUT + 3 * I_EX;
    for (int it = gw; it < DEPTH * PER_L; it += NGW) {
        const int l = it / PER_L; int r = it % PER_L;
        if (r < I_IN) { const int kb = r / 224, nb = r % 224, n0 = nb * 32, src = n0 + (n0 >= 5632 ? 12 : (n0 >= 3584 ? 4 : 0));
            transpose_item(P->in[I_WIN] + (size_t)l * DM * NIN, DM, NIN, (bf16_t*)(ws + WS_WIN + l * SZ_WIN), src, n0, kb * 64, scr, lane); continue; }
        r -= I_IN;
        if (r < I_OUT) { const int kb = r / 64, nb = r % 64;
            transpose_item(P->in[I_WOUT] + (size_t)l * DM * DM, DM, DM, (bf16_t*)(ws + WS_WOUT + l * SZ_WOUT), nb * 32, nb * 32, kb * 64, scr, lane); continue; }
        r -= I_OUT;
        if (r < 2 * I_EX) { const int up = r >= I_EX; if (up) r -= I_EX;
            const int e = r >> 10, q = r & 1023, kb = q >> 5, nb = q & 31, n0 = nb * 32, dst = (n0 >> 7) * 256 + (n0 & 127) + (up ? 128 : 0);
            const float* W = P->in[up ? I_WU : I_WG] + (size_t)(l * NE + e) * DM * DFF;
            transpose_item(W, DM, DFF, (bf16_t*)(ws + WS_WGU + l * SZ_WGU) + (size_t)e * 2048 * DM, n0, dst, kb * 64, scr, lane); continue; }
        r -= 2 * I_EX;
        { const int e = r >> 10, q = r & 1023, kb = q >> 6, nb = q & 63;
            transpose_item(P->in[I_WD] + (size_t)(l * NE + e) * DFF * DM, DFF, DM, (bf16_t*)(ws + WS_WD + l * SZ_WD) + (size_t)e * DM * DFF, nb * 32, nb * 32, kb * 64, scr, lane); }
    }
    for (int idx = F.vcu * 512 + tid; idx < DEPTH * 48 * DM; idx += F.G * 512) {
        const int l = idx / (48 * DM), r = idx % (48 * DM), c = r / DM, k = r % DM;
        if (c < 12) { const int col = c < 4 ? 3584 + c : 5636 + (c - 4);
            ((float*)(ws + WS_GW))[(size_t)(l * 12 + c) * DM + k] = P->in[I_WIN][(size_t)l * DM * NIN + (size_t)k * NIN + col]; }
        else { const int cc = c - 12;
            const float v = cc < 4 ? P->in[I_WRG][((size_t)l * DM + k) * 4 + cc] : P->in[I_WRE][((size_t)l * DM + k) * 32 + (cc - 4)];
            ((float*)(ws + WS_RW))[(size_t)(l * 36 + cc) * DM + k] = v; }
    }
    for (int idx = F.vcu * 512 + tid; idx < DEPTH * 48 * DM; idx += F.G * 512) {
        const int l = idx / (48 * DM), r = idx % (48 * DM), cc = r / DM, k = r % DM;
        const float v = cc < 4 ? P->in[I_WRG][((size_t)l * DM + k) * 4 + cc] : (cc < 36 ? P->in[I_WRE][((size_t)l * DM + k) * 32 + (cc - 4)] : 0.f);
        const unsigned hi = f2bf(v); const float lo = v - __builtin_bit_cast(float, hi << 16);
        bf16_t* rb = (bf16_t*)(ws + WS_RWB) + (size_t)l * 2 * 48 * DM;
        rb[(size_t)cc * DM + k] = (bf16_t)hi; rb[(size_t)(48 + cc) * DM + k] = (bf16_t)f2bf(lo);
    }
}

struct MoeTab { LAS int* tstart; LAS int* cnt; };
__device__ __forceinline__ MoeTab moe_tab(Frame& F, int l) {
    PHASE_BEGIN();
    MoeTab mt; mt.tstart = (LAS int*)(F.lds + LDSCTL_OFF + 1024); mt.cnt = (LAS int*)(F.lds + LDSCTL_OFF + 1024 + 256);
    const unsigned* gc = (const unsigned*)(ws + WS_CTL) + CW_CNT + l * 64;
    if (tid < NE) mt.cnt[tid] = (int)__hip_atomic_load(gc + tid, __ATOMIC_RELAXED, __HIP_MEMORY_SCOPE_AGENT);
    __syncthreads();
    if (tid == 0) { int s = 0; for (int e = 0; e < NE; ++e) { mt.tstart[e] = s; s += (mt.cnt[e] + 255) >> 8; } mt.tstart[NE] = s; }
    __syncthreads();
    return mt;
}

template <int MODE>
__device__ __forceinline__ void phase_norm1(Frame& F, int l, const float* xin, float* xout) {
    PHASE_BEGIN();
    LAS f32x4* gwl = (LAS f32x4*)F.lds;
    MoeTab mt{};
    if (MODE != 0) mt = moe_tab(F, l - 1);
    if (MODE != 2) { const f32x4* src = (const f32x4*)(ws + WS_GW + (size_t)l * 12 * DM * 4);
        for (int i = tid; i < 12 * DM / 4; i += 512) gwl[i] = src[i];
        __syncthreads(); }
    const int gw = F.vcu * NWAVES + wave, NGW = F.G * NWAVES;
    const bf16_t* ys = (const bf16_t*)(ws + WS_Z);
    const unsigned* route = (const unsigned*)(ws + WS_ROUTE);
    bf16_t* hb = (bf16_t*)(ws + WS_HB);
    float* gates = (float*)(ws + WS_GATES);
    const float* g1 = P->in[I_N1G] + (size_t)(MODE == 2 ? 0 : l) * DM;
    for (int m = gw; m < T; m += NGW) {
        const f32x4* xr = (const f32x4*)(xin + (size_t)m * DM) + lane;
        f32x4 v[8];
#pragma unroll
        for (int j = 0; j < 8; ++j) v[j] = xr[64 * j];
        if (MODE != 0) {
            const u32x4 r0 = *(const u32x4*)(route + (size_t)m * 8); const u32x2 r1 = *(const u32x2*)(route + (size_t)m * 8 + 4);
            const int s0 = mt.tstart[r0.x] * 256 + (int)r0.y, s1 = mt.tstart[r0.z] * 256 + (int)r0.w;
            const unsigned w0u = r1.x, w1u = r1.y;
            const float w0 = __builtin_bit_cast(float, w0u), w1 = __builtin_bit_cast(float, w1u);
            const u32x2* y0 = (const u32x2*)(ys + (size_t)s0 * DM) + lane; const u32x2* y1 = (const u32x2*)(ys + (size_t)s1 * DM) + lane;
#pragma unroll
            for (int j = 0; j < 8; ++j) { const u32x2 a = y0[64 * j], b = y1[64 * j];
                v[j].x += w0 * bflo(a.x) + w1 * bflo(b.x); v[j].y += w0 * bfhi(a.x) + w1 * bfhi(b.x);
                v[j].z += w0 * bflo(a.y) + w1 * bflo(b.y); v[j].w += w0 * bfhi(a.y) + w1 * bfhi(b.y); }
            f32x4* xo = (f32x4*)(xout + (size_t)m * DM) + lane;
#pragma unroll
            for (int j = 0; j < 8; ++j) xo[64 * j] = v[j];
        }
        if (MODE == 2) continue;
        float ss = 0.f;
#pragma unroll
        for (int j = 0; j < 8; ++j) ss += (v[j].x * v[j].x + v[j].y * v[j].y) + (v[j].z * v[j].z + v[j].w * v[j].w);
        const float rstd = __builtin_amdgcn_rsqf(wave_sum(ss) * (1.f / DM) + EPS);
        u32x2* o8 = (u32x2*)(hb + (size_t)m * DM) + lane;
#pragma unroll
        for (int j = 0; j < 8; ++j) { const f32x4 g = ((const f32x4*)g1)[64 * j + lane]; v[j] = v[j] * rstd * g;
            u32x2 o; o.x = pk2(v[j].x, v[j].y); o.y = pk2(v[j].z, v[j].w); o8[64 * j] = o; }
        float gs[12];
#pragma unroll
        for (int c = 0; c < 12; ++c) { float a = 0.f;
#pragma unroll
            for (int j = 0; j < 8; ++j) { const f32x4 w = gwl[c * 512 + 64 * j + lane]; a += (v[j].x * w.x + v[j].y * w.y) + (v[j].z * w.z + v[j].w * w.w); }
            gs[c] = wave_sum(a); if (c & 1) asm volatile("" ::: "memory"); }
        if (lane == 0) { f32x4* go = (f32x4*)(gates + (size_t)m * 12);
            go[0] = (f32x4){gs[0], gs[1], gs[2], gs[3]}; go[1] = (f32x4){gs[4], gs[5], gs[6], gs[7]}; go[2] = (f32x4){gs[8], gs[9], gs[10], gs[11]}; }
    }
}

__device__ __forceinline__ float block_excl_sum(int lane, int wave, float tot, LAS float* sc) {
    float inc = tot;
#pragma unroll
    for (int o = 1; o < 64; o <<= 1) { const float t = __shfl_up(inc, o); if (lane >= o) inc += t; }
    __syncthreads();
    if (lane == 63) sc[wave] = inc;
    __syncthreads();
    float base = 0.f;
    for (int w = 0; w < wave; ++w) base += sc[w];
    return base + inc - tot;
}
__device__ __forceinline__ float block_excl_max(int lane, int wave, float tot, LAS float* sc) {
    float inc = tot;
#pragma unroll
    for (int o = 1; o < 64; o <<= 1) { const float t = __shfl_up(inc, o); if (lane >= o) inc = fmaxf(inc, t); }
    __syncthreads();
    if (lane == 63) sc[wave] = inc;
    __syncthreads();
    float base = -INFINITY;
    for (int w = 0; w < wave; ++w) base = fmaxf(base, sc[w]);
    const float prev = __shfl_up(inc, 1);
    return fmaxf(base, lane == 0 ? -INFINITY : prev);
}

__device__ __forceinline__ void phase_prep(Frame& F, int l) {
    PHASE_BEGIN();
    bf16_t* z = (bf16_t*)(ws + WS_Z);
    bf16_t* y = (bf16_t*)(ws + WS_Y);
    const float* gates = (const float*)(ws + WS_GATES);
    float* pref = (float*)(ws + WS_PREF);
    for (int it = F.vcu; it < 32; it += F.G) {
        const int kind = it >> 4, bh = it & 15, b = bh >> 2, h = bh & 3;
        LAS float* sc = (LAS float*)(F.lds + 65536);
        const int s0 = tid * 8;
        float v[8], a[8];
        if (kind == 0) {
            const float fb = P->in[I_FFB][l * NH + h];
            float run = 0.f;
#pragma unroll
            for (int i = 0; i < 8; ++i) { run += log_sigmoidf_(gates[(size_t)(b * SEQ + s0 + i) * 12 + h] + fb); v[i] = run; }
            const float base = block_excl_sum(lane, wave, run, sc);
#pragma unroll
            for (int i = 0; i < 8; ++i) pref[(size_t)(0 * 16 + bh) * SEQ + s0 + i] = base + v[i];
        } else {
            const float fb = P->in[I_MFB][l * NH + h], ib = P->in[I_MIB][l * NH + h];
            float run = 0.f;
#pragma unroll
            for (int i = 0; i < 8; ++i) { run += log_sigmoidf_(gates[(size_t)(b * SEQ + s0 + i) * 12 + 8 + h] + fb); v[i] = run; }
            const float base = block_excl_sum(lane, wave, run, sc);
            float mx = -INFINITY;
#pragma unroll
            for (int i = 0; i < 8; ++i) { v[i] += base; a[i] = gates[(size_t)(b * SEQ + s0 + i) * 12 + 4 + h] + ib - v[i]; mx = fmaxf(mx, a[i]); }
            float pm = fmaxf(block_excl_max(lane, wave, mx, sc + 16), 0.f);
#pragma unroll
            for (int i = 0; i < 8; ++i) { pm = fmaxf(pm, a[i]);
                pref[(size_t)(1 * 16 + bh) * SEQ + s0 + i] = v[i]; pref[(size_t)(2 * 16 + bh) * SEQ + s0 + i] = a[i]; pref[(size_t)(3 * 16 + bh) * SEQ + s0 + i] = pm; }
        }
        __syncthreads();
    }
    const int gw = F.vcu * NWAVES + wave, NGW = F.G * NWAVES;
    const float inv = __builtin_amdgcn_exp2f(-(float)lane * (13.287712379549449f / 64.f));
    const float gq0 = P->in[I_FQN][l * HD + lane], gq1 = P->in[I_FQN][l * HD + 64 + lane], gk0 = P->in[I_FKN][l * HD + lane], gk1 = P->in[I_FKN][l * HD + 64 + lane];
    const float* cw = P->in[I_CONVW] + (size_t)l * 3 * 512; const float* gcv = P->in[I_HNG] + (size_t)l * DM + 1536;
    for (int m = gw; m < T; m += NGW) {
        bf16_t* zr = z + (size_t)m * NZ;
        const float ang = (float)((const int*)P->in[I_POS])[m] * inv;
        const float C1 = 0.15915493667125702f, C2 = 6.420638326565253e-09f;
        const float hi = ang * C1, lo = __builtin_fmaf(ang, C1, -hi);
        const float rev = (hi - __builtin_floorf(hi)) + (lo + ang * C2);
        const float cs = __builtin_amdgcn_cosf(rev), sn = __builtin_amdgcn_sinf(rev);
#pragma unroll
        for (int qk = 0; qk < 2; ++qk)
#pragma unroll
            for (int h = 0; h < NH; ++h) { bf16_t* p = zr + (qk ? ZK_R : ZQ_R) + h * HD + lane;
                const float t1 = bf2f(p[0]), t2 = bf2f(p[64]);
                p[0] = (bf16_t)f2bf(t1 * cs - t2 * sn); p[64] = (bf16_t)f2bf(t1 * sn + t2 * cs); }
#pragma unroll
        for (int qk = 0; qk < 2; ++qk)
#pragma unroll
            for (int h = 0; h < NH; ++h) { bf16_t* p = zr + (qk ? ZK_F : ZQ_F) + h * HD + lane;
                const float t1 = bf2f(p[0]), t2 = bf2f(p[64]);
                const float rstd = __builtin_amdgcn_rsqf(wave_sum(t1 * t1 + t2 * t2) * (1.f / HD) + EPS);
                p[0] = (bf16_t)f2bf(t1 * rstd * (qk ? gk0 : gq0)); p[64] = (bf16_t)f2bf(t2 * rstd * (qk ? gk1 : gq1)); }
        { const int s = m & (SEQ - 1), c0 = 8 * lane;
            float u[3][8];
#pragma unroll
            for (int d = 0; d < 3; ++d) {
                if (s - (2 - d) >= 0) { const bf16_t* zz = zr - (size_t)(2 - d) * NZ;
                    const u32x4 hc = *(const u32x4*)(zz + ZH_C + c0), cc = *(const u32x4*)(zz + ZC_C + c0);
                    u[d][0] = bflo(hc.x) * bflo(cc.x); u[d][1] = bfhi(hc.x) * bfhi(cc.x); u[d][2] = bflo(hc.y) * bflo(cc.y); u[d][3] = bfhi(hc.y) * bfhi(cc.y);
                    u[d][4] = bflo(hc.z) * bflo(cc.z); u[d][5] = bfhi(hc.z) * bfhi(cc.z); u[d][6] = bflo(hc.w) * bflo(cc.w); u[d][7] = bfhi(hc.w) * bfhi(cc.w);
                } else {
#pragma unroll
                    for (int i = 0; i < 8; ++i) u[d][i] = 0.f; }
            }
            const u32x4 cb = *(const u32x4*)(zr + ZB_C + c0);
            const float cbv[8] = {bflo(cb.x), bfhi(cb.x), bflo(cb.y), bfhi(cb.y), bflo(cb.z), bfhi(cb.z), bflo(cb.w), bfhi(cb.w)};
            float o[8], ss = 0.f;
#pragma unroll
            for (int i = 0; i < 8; ++i) { o[i] = cbv[i] * (cw[c0 + i] * u[0][i] + cw[512 + c0 + i] * u[1][i] + cw[1024 + c0 + i] * u[2][i]); ss += o[i] * o[i]; }
            ss += __shfl_xor(ss, 1); ss += __shfl_xor(ss, 2); ss += __shfl_xor(ss, 4); ss += __shfl_xor(ss, 8);
            const float rstd = __builtin_amdgcn_rsqf(ss * (1.f / HD) + EPS);
            u32x4 w; w.x = pk2(o[0] * rstd * gcv[c0 + 0], o[1] * rstd * gcv[c0 + 1]); w.y = pk2(o[2] * rstd * gcv[c0 + 2], o[3] * rstd * gcv[c0 + 3]);
            w.z = pk2(o[4] * rstd * gcv[c0 + 4], o[5] * rstd * gcv[c0 + 5]); w.w = pk2(o[6] * rstd * gcv[c0 + 6], o[7] * rstd * gcv[c0 + 7]);
            *(u32x4*)(y + (size_t)m * DM + 1536 + c0) = w; }
    }
}

__device__ __forceinline__ void phase_mix_naive(Frame& F, int l) {
    PHASE_BEGIN();
    const bf16_t* z = (const bf16_t*)(ws + WS_Z);
    bf16_t* y = (bf16_t*)(ws + WS_Y);
    const float* pref = (const float*)(ws + WS_PREF);
    LAS float* qs = (LAS float*)F.lds; LAS float* ks = qs + 64 * 132; LAS float* vs = ks + 64 * 132; LAS float* ps = vs + 64 * 128;
    LAS float* rowA = ps + 64 * 68; LAS float* rowB = rowA + 64; LAS float* colA = rowB + 64;
    const int lr = tid >> 3, ldc = (tid & 7) * 16;
    const int rg = tid >> 4, cg = tid & 15;
    const int rg2 = tid >> 5, eg = tid & 31;
    const float kscale = 0.08838834764831845f;
    for (int it = F.vcu; it < 3 * 16 * 64; it += F.G) {
        const int tb = 63 - it / 48, rem = it % 48, mx = rem >> 4, bh = rem & 15, b = bh >> 2, h = bh & 3, t0 = tb * 64;
        const int qcol = (mx == 0 ? ZQ_R : (mx == 1 ? ZQ_F : ZQ_M)) + h * HD, kcol = (mx == 0 ? ZK_R : (mx == 1 ? ZK_F : ZK_M)) + h * HD, vcol = (mx == 0 ? ZV_R : (mx == 1 ? ZV_F : ZV_M)) + h * HD;
        const float lg2g = __builtin_log2f(1.0f - __builtin_amdgcn_exp2f(-5.0f - (float)h));
        __syncthreads();
        { const bf16_t* src = z + (size_t)(b * SEQ + t0 + lr) * NZ + qcol + ldc; const u32x4 a = *(const u32x4*)src, c = *(const u32x4*)(src + 8);
            LAS f32x4* d = (LAS f32x4*)(qs + lr * 132 + ldc);
            d[0] = (f32x4){bflo(a.x), bfhi(a.x), bflo(a.y), bfhi(a.y)}; d[1] = (f32x4){bflo(a.z), bfhi(a.z), bflo(a.w), bfhi(a.w)};
            d[2] = (f32x4){bflo(c.x), bfhi(c.x), bflo(c.y), bfhi(c.y)}; d[3] = (f32x4){bflo(c.z), bfhi(c.z), bflo(c.w), bfhi(c.w)}; }
        if (tid < 64) { const int t = t0 + tid;
            rowA[tid] = mx == 1 ? pref[(size_t)(0 * 16 + bh) * SEQ + t] : (mx == 2 ? pref[(size_t)(3 * 16 + bh) * SEQ + t] : 0.f);
            rowB[tid] = mx == 2 ? pref[(size_t)(1 * 16 + bh) * SEQ + t] : 0.f; }
        f32x4 acc[4]; float rsum[4];
#pragma unroll
        for (int a = 0; a < 4; ++a) { acc[a] = (f32x4){0.f, 0.f, 0.f, 0.f}; rsum[a] = 0.f; }
        for (int kt = 0; kt <= tb; ++kt) {
            const int j0 = kt * 64;
            __syncthreads();
            { const bf16_t* src = z + (size_t)(b * SEQ + j0 + lr) * NZ + kcol + ldc; const u32x4 a = *(const u32x4*)src, c = *(const u32x4*)(src + 8);
                LAS f32x4* d = (LAS f32x4*)(ks + lr * 132 + ldc);
                d[0] = (f32x4){bflo(a.x), bfhi(a.x), bflo(a.y), bfhi(a.y)}; d[1] = (f32x4){bflo(a.z), bfhi(a.z), bflo(a.w), bfhi(a.w)};
                d[2] = (f32x4){bflo(c.x), bfhi(c.x), bflo(c.y), bfhi(c.y)}; d[3] = (f32x4){bflo(c.z), bfhi(c.z), bflo(c.w), bfhi(c.w)}; }
            { const bf16_t* src = z + (size_t)(b * SEQ + j0 + lr) * NZ + vcol + ldc; const u32x4 a = *(const u32x4*)src, c = *(const u32x4*)(src + 8);
                LAS f32x4* d = (LAS f32x4*)(vs + lr * 128 + ldc);
                d[0] = (f32x4){bflo(a.x), bfhi(a.x), bflo(a.y), bfhi(a.y)}; d[1] = (f32x4){bflo(a.z), bfhi(a.z), bflo(a.w), bfhi(a.w)};
                d[2] = (f32x4){bflo(c.x), bfhi(c.x), bflo(c.y), bfhi(c.y)}; d[3] = (f32x4){bflo(c.z), bfhi(c.z), bflo(c.w), bfhi(c.w)}; }
            if (tid < 64) colA[tid] = mx == 1 ? pref[(size_t)(0 * 16 + bh) * SEQ + j0 + tid] : (mx == 2 ? pref[(size_t)(2 * 16 + bh) * SEQ + j0 + tid] : 0.f);
            __syncthreads();
            float dot[2][4];
#pragma unroll
            for (int a = 0; a < 2; ++a)
#pragma unroll
                for (int i = 0; i < 4; ++i) dot[a][i] = 0.f;
#pragma unroll 4
            for (int d4 = 0; d4 < 32; ++d4) {
                const f32x4 qa = *(const LAS f32x4*)(qs + (2 * rg) * 132 + 4 * d4), qb = *(const LAS f32x4*)(qs + (2 * rg + 1) * 132 + 4 * d4);
#pragma unroll
                for (int i = 0; i < 4; ++i) { const f32x4 kk = *(const LAS f32x4*)(ks + (4 * cg + i) * 132 + 4 * d4);
                    dot[0][i] += (qa.x * kk.x + qa.y * kk.y) + (qa.z * kk.z + qa.w * kk.w); dot[1][i] += (qb.x * kk.x + qb.y * kk.y) + (qb.z * kk.z + qb.w * kk.w); }
            }
#pragma unroll
            for (int a = 0; a < 2; ++a) { const int r = 2 * rg + a, t = t0 + r; const float ra = rowA[r];
                f32x4 pv;
#pragma unroll
                for (int i = 0; i < 4; ++i) { const int j = 4 * cg + i, jg = j0 + j; float p;
                    if (mx == 0) p = dot[a][i] * kscale * __builtin_amdgcn_exp2f((float)(t - jg) * lg2g);
                    else if (mx == 1) p = __expf(dot[a][i] * kscale + ra - colA[j]);
                    else p = dot[a][i] * kscale * __expf(colA[j] - ra);
                    pv[i] = jg <= t ? p : 0.f; }
                *(LAS f32x4*)(ps + r * 68 + 4 * cg) = pv; }
            __syncthreads();
#pragma unroll 4
            for (int j4 = 0; j4 < 16; ++j4) {
                f32x4 pp[4];
#pragma unroll
                for (int a = 0; a < 4; ++a) pp[a] = *(const LAS f32x4*)(ps + (4 * rg2 + a) * 68 + 4 * j4);
#pragma unroll
                for (int jj = 0; jj < 4; ++jj) { const f32x4 vv = *(const LAS f32x4*)(vs + (4 * j4 + jj) * 128 + 4 * eg);
#pragma unroll
                    for (int a = 0; a < 4; ++a) { acc[a] += pp[a][jj] * vv; rsum[a] += pp[a][jj]; } }
            }
        }
        const float* gn = P->in[I_HNG] + (size_t)l * DM + mx * 512 + h * HD + 4 * eg;
#pragma unroll
        for (int a = 0; a < 4; ++a) { const int r = 4 * rg2 + a; const size_t m = (size_t)b * SEQ + t0 + r;
            f32x4 o = acc[a];
            if (mx == 1) o = o * (1.0f / rsum[a]);
            if (mx == 2) { const float den = fmaxf(fabsf(rsum[a]), __expf(-rowB[r] - rowA[r])); o = o * (1.0f / den);
                const u32x2 g = *(const u32x2*)(z + m * NZ + ZO_M + h * HD + 4 * eg);
                o.x *= sigmoidf_(bflo(g.x)); o.y *= sigmoidf_(bfhi(g.x)); o.z *= sigmoidf_(bflo(g.y)); o.w *= sigmoidf_(bfhi(g.y)); }
            float ss = (o.x * o.x + o.y * o.y) + (o.z * o.z + o.w * o.w);
            ss += __shfl_xor(ss, 1); ss += __shfl_xor(ss, 2); ss += __shfl_xor(ss, 4); ss += __shfl_xor(ss, 8); ss += __shfl_xor(ss, 16);
            const float rstd = __builtin_amdgcn_rsqf(ss * (1.f / HD) + EPS);
            o = o * rstd; o.x *= gn[0]; o.y *= gn[1]; o.z *= gn[2]; o.w *= gn[3];
            if (mx == 0) { const u32x2 g = *(const u32x2*)(z + m * NZ + ZG_R + h * HD + 4 * eg);
                o.x *= siluf_(bflo(g.x)); o.y *= siluf_(bfhi(g.x)); o.z *= siluf_(bflo(g.y)); o.w *= siluf_(bfhi(g.y)); }
            u32x2 w; w.x = pk2(o.x, o.y); w.y = pk2(o.z, o.w);
            *(u32x2*)(y + m * DM + mx * 512 + h * HD + 4 * eg) = w; }
    }
}


constexpr int TS = 136, TILE_B = 128 * TS * 2;
typedef short s16x4 __attribute__((ext_vector_type(4)));
constexpr size_t WS_KV = WS_STATE;
constexpr size_t WS_NB = WS_KV + (size_t)2 * 16 * 32 * 16384 * 4;
constexpr size_t WS_MS = WS_NB + (size_t)16 * 32 * 128 * 4;
static_assert(WS_MS + 16 * 32 * 4 * 4 <= WS_END, "state scratch");
__device__ __forceinline__ bf16x8 frag_row(const LAS bf16_t* T, int row, int k0) { return *(const LAS bf16x8*)(T + row * TS + k0); }
__device__ __forceinline__ bf16x8 frag_tr2(const LAS bf16_t* T, int rA, int rB, int c0, int lane) {
    const int i = lane & 15, q = i >> 2, p = i & 3;
    const s16x4 a = __builtin_amdgcn_ds_read_tr16_b64_v4i16((LAS s16x4*)(T + (rA + q) * TS + c0 + 4 * p));
    const s16x4 b = __builtin_amdgcn_ds_read_tr16_b64_v4i16((LAS s16x4*)(T + (rB + q) * TS + c0 + 4 * p));
    return (bf16x8){a[0], a[1], a[2], a[3], b[0], b[1], b[2], b[3]};
}
__device__ __forceinline__ bf16x8 frag_tr(const LAS bf16_t* T, int k0, int c0, int lane) { const int g = lane >> 4; return frag_tr2(T, k0 + 8 * g, k0 + 8 * g + 4, c0, lane); }
__device__ __forceinline__ bf16x8 frag_trp(const LAS bf16_t* T, int s, int c0, int lane) { const int g = lane >> 4; return frag_tr2(T, 32 * s + 4 * g, 32 * s + 16 + 4 * g, c0, lane); }
__device__ __forceinline__ bf16x8 pack_acc(const f32x4 a, const f32x4 b) { u32x4 w; w.x = pk2(a[0], a[1]); w.y = pk2(a[2], a[3]); w.z = pk2(b[0], b[1]); w.w = pk2(b[2], b[3]); return __builtin_bit_cast(bf16x8, w); }
#define MFMA16(a, b, c) __builtin_amdgcn_mfma_f32_16x16x32_bf16((a), (b), (c), 0, 0, 0)
__device__ __forceinline__ void tile_load(LAS bf16_t* Tl, const bf16_t* src, int tid) {
    const int row = tid >> 2, c = (tid & 3) * 32; const u32x4* s = (const u32x4*)(src + (size_t)row * NZ + c); LAS u32x4* d = (LAS u32x4*)(Tl + row * TS + c);
    const u32x4 v0 = s[0], v1 = s[1], v2 = s[2], v3 = s[3]; d[0] = v0; d[1] = v1; d[2] = v2; d[3] = v3;
}
struct ChunkGates { float b0, b1, a0, a1, bL; };
__device__ __forceinline__ ChunkGates chunk_gates(const float* gates, int row0, int h, float mfb, float mib, int lane) {
    const float* g0 = gates + (size_t)(row0 + 2 * lane) * 12;
    const float lf0 = log_sigmoidf_(g0[8 + h] + mfb), lf1 = log_sigmoidf_(g0[12 + 8 + h] + mfb);
    const float s = lf0 + lf1; float inc = s;
#pragma unroll
    for (int o = 1; o < 64; o <<= 1) { const float t = __shfl_up(inc, o); if (lane >= o) inc += t; }
    ChunkGates cg; cg.b0 = inc - s + lf0; cg.b1 = inc; cg.bL = __shfl(inc, 63);
    cg.a0 = g0[4 + h] + mib - cg.b0; cg.a1 = g0[12 + 4 + h] + mib - cg.b1; return cg;
}

__device__ __forceinline__ void phase_c1(Frame& F, int l) {
    PHASE_BEGIN();
    bf16_t* z = (bf16_t*)(ws + WS_Z);
    bf16_t* y = (bf16_t*)(ws + WS_Y);
    const float* gates = (const float*)(ws + WS_GATES);
    float* pref = (float*)(ws + WS_PREF);
    for (int it = F.vcu; it < 16; it += F.G) {
        const int bh = it, b = bh >> 2, h = bh & 3; LAS float* sc = (LAS float*)(F.lds + 65536); const int s0 = tid * 8; float v[8];
        const float fb = P->in[I_FFB][l * NH + h]; float run = 0.f;
#pragma unroll
        for (int i = 0; i < 8; ++i) { run += log_sigmoidf_(gates[(size_t)(b * SEQ + s0 + i) * 12 + h] + fb); v[i] = run; }
        const float base = block_excl_sum(lane, wave, run, sc);
#pragma unroll
        for (int i = 0; i < 8; ++i) pref[(size_t)bh * SEQ + s0 + i] = (base + v[i]) * 1.4426950408889634f;
        __syncthreads();
    }
    {
        const int gw = F.vcu * NWAVES + wave, NGW = F.G * NWAVES;
        const float* cw = P->in[I_CONVW] + (size_t)l * 3 * 512; const float* gcv = P->in[I_HNG] + (size_t)l * DM + 1536;
        for (int m = gw; m < T; m += NGW) {
            bf16_t* zr = z + (size_t)m * NZ;
#pragma unroll
            for (int qk = 0; qk < 2; ++qk) { bf16_t* p = zr + (qk ? ZK_F : ZQ_F) + 8 * lane;
                const u32x4 v = *(const u32x4*)p; float t[8] = {bflo(v.x), bfhi(v.x), bflo(v.y), bfhi(v.y), bflo(v.z), bfhi(v.z), bflo(v.w), bfhi(v.w)};
                float ss = 0.f;
#pragma unroll
                for (int q = 0; q < 8; ++q) ss += t[q] * t[q];
                ss += __shfl_xor(ss, 1); ss += __shfl_xor(ss, 2); ss += __shfl_xor(ss, 4); ss += __shfl_xor(ss, 8);
                const float rstd = __builtin_amdgcn_rsqf(ss * (1.f / HD) + EPS);
                const float* gp = P->in[qk ? I_FKN : I_FQN] + l * HD + ((8 * lane) & 127); const f32x4 ga = *(const f32x4*)gp, gb = *(const f32x4*)(gp + 4);
                u32x4 o; o.x = pk2(t[0] * rstd * ga.x, t[1] * rstd * ga.y); o.y = pk2(t[2] * rstd * ga.z, t[3] * rstd * ga.w); o.z = pk2(t[4] * rstd * gb.x, t[5] * rstd * gb.y); o.w = pk2(t[6] * rstd * gb.z, t[7] * rstd * gb.w);
                *(u32x4*)p = o; }
            { const int s = m & (SEQ - 1), c0 = 8 * lane;
                float u[3][8];
#pragma unroll
                for (int d = 0; d < 3; ++d) {
                    if (s - (2 - d) >= 0) { const bf16_t* zz = zr - (size_t)(2 - d) * NZ;
                        const u32x4 hc = *(const u32x4*)(zz + ZH_C + c0), cc = *(const u32x4*)(zz + ZC_C + c0);
                        u[d][0] = bflo(hc.x) * bflo(cc.x); u[d][1] = bfhi(hc.x) * bfhi(cc.x); u[d][2] = bflo(hc.y) * bflo(cc.y); u[d][3] = bfhi(hc.y) * bfhi(cc.y);
                        u[d][4] = bflo(hc.z) * bflo(cc.z); u[d][5] = bfhi(hc.z) * bfhi(cc.z); u[d][6] = bflo(hc.w) * bflo(cc.w); u[d][7] = bfhi(hc.w) * bfhi(cc.w);
                    } else {
#pragma unroll
                        for (int i = 0; i < 8; ++i) u[d][i] = 0.f; }
                }
                const u32x4 cb = *(const u32x4*)(zr + ZB_C + c0);
                const float cbv[8] = {bflo(cb.x), bfhi(cb.x), bflo(cb.y), bfhi(cb.y), bflo(cb.z), bfhi(cb.z), bflo(cb.w), bfhi(cb.w)};
                float o[8], ss = 0.f;
#pragma unroll
                for (int i = 0; i < 8; ++i) { o[i] = cbv[i] * (cw[c0 + i] * u[0][i] + cw[512 + c0 + i] * u[1][i] + cw[1024 + c0 + i] * u[2][i]); ss += o[i] * o[i]; }
                ss += __shfl_xor(ss, 1); ss += __shfl_xor(ss, 2); ss += __shfl_xor(ss, 4); ss += __shfl_xor(ss, 8);
                const float rstd = __builtin_amdgcn_rsqf(ss * (1.f / HD) + EPS);
                u32x4 w; w.x = pk2(o[0] * rstd * gcv[c0 + 0], o[1] * rstd * gcv[c0 + 1]); w.y = pk2(o[2] * rstd * gcv[c0 + 2], o[3] * rstd * gcv[c0 + 3]);
                w.z = pk2(o[4] * rstd * gcv[c0 + 4], o[5] * rstd * gcv[c0 + 5]); w.w = pk2(o[6] * rstd * gcv[c0 + 6], o[7] * rstd * gcv[c0 + 7]);
                *(u32x4*)(y + (size_t)m * DM + 1536 + c0) = w; }
        }
    }
    LAS bf16_t* Kt = (LAS bf16_t*)F.lds; LAS bf16_t* Vt = Kt + 128 * TS; LAS float* wj = (LAS float*)(F.lds + 2 * TILE_B);
    float* KV = (float*)(ws + WS_KV); float* NB = (float*)(ws + WS_NB); float* MS = (float*)(ws + WS_MS);
    const float kscale = 0.08838834764831845f;
    for (int it = F.vcu; it < 2 * 16 * 32; it += F.G) {
        const int kind = it >> 9, bh = (it >> 5) & 15, n = it & 31, b = bh >> 2, h = bh & 3, row0 = b * SEQ + n * 128;
        __syncthreads();
        const int row = tid >> 2;
        if (kind == 0) {
            const int i0 = (tid & 3) * 16; bf16_t* zr = z + (size_t)(row0 + row) * NZ;
            const float posf = (float)((const int*)P->in[I_POS])[row0 + row];
            const float lg2g = __builtin_log2f(1.0f - __builtin_amdgcn_exp2f(-5.0f - (float)h));
            const float kw = kscale * __builtin_amdgcn_exp2f((float)(127 - row) * lg2g);
            float cs[16], sn[16];
#pragma unroll
            for (int ii = 0; ii < 16; ++ii) { const float inv = __builtin_amdgcn_exp2f(-(float)(i0 + ii) * (13.287712379549449f / 64.f)); const float ang = posf * inv;
                const float C1 = 0.15915493667125702f, C2 = 6.420638326565253e-09f; const float hi = ang * C1, lo = __builtin_fmaf(ang, C1, -hi); const float rev = (hi - __builtin_floorf(hi)) + (lo + ang * C2);
                cs[ii] = __builtin_amdgcn_cosf(rev); sn[ii] = __builtin_amdgcn_sinf(rev); }
#pragma unroll
            for (int qk = 0; qk < 2; ++qk) { bf16_t* p = zr + (qk ? ZK_R : ZQ_R) + h * HD + i0;
                const u32x4 a0 = *(const u32x4*)p, a1 = *(const u32x4*)(p + 8), b0 = *(const u32x4*)(p + 64), b1 = *(const u32x4*)(p + 72);
                const unsigned aw[8] = {a0.x, a0.y, a0.z, a0.w, a1.x, a1.y, a1.z, a1.w}, bw[8] = {b0.x, b0.y, b0.z, b0.w, b1.x, b1.y, b1.z, b1.w};
                unsigned oa[8], ob[8], ka[8], kb[8];
#pragma unroll
                for (int w2 = 0; w2 < 8; ++w2) { const float t1l = bflo(aw[w2]), t1h = bfhi(aw[w2]), t2l = bflo(bw[w2]), t2h = bfhi(bw[w2]);
                    const float r1l = t1l * cs[2 * w2] - t2l * sn[2 * w2], r1h = t1h * cs[2 * w2 + 1] - t2h * sn[2 * w2 + 1];
                    const float r2l = t1l * sn[2 * w2] + t2l * cs[2 * w2], r2h = t1h * sn[2 * w2 + 1] + t2h * cs[2 * w2 + 1];
                    oa[w2] = pk2(r1l, r1h); ob[w2] = pk2(r2l, r2h);
                    ka[w2] = pk2(bflo(oa[w2]) * kw, bfhi(oa[w2]) * kw); kb[w2] = pk2(bflo(ob[w2]) * kw, bfhi(ob[w2]) * kw); }
                *(u32x4*)p = (u32x4){oa[0], oa[1], oa[2], oa[3]}; *(u32x4*)(p + 8) = (u32x4){oa[4], oa[5], oa[6], oa[7]};
                *(u32x4*)(p + 64) = (u32x4){ob[0], ob[1], ob[2], ob[3]}; *(u32x4*)(p + 72) = (u32x4){ob[4], ob[5], ob[6], ob[7]};
                if (qk) { LAS u32x4* d = (LAS u32x4*)(Kt + row * TS + i0); d[0] = (u32x4){ka[0], ka[1], ka[2], ka[3]}; d[1] = (u32x4){ka[4], ka[5], ka[6], ka[7]};
                    LAS u32x4* d2 = (LAS u32x4*)(Kt + row * TS + 64 + i0); d2[0] = (u32x4){kb[0], kb[1], kb[2], kb[3]}; d2[1] = (u32x4){kb[4], kb[5], kb[6], kb[7]}; } }
            tile_load(Vt, z + (size_t)row0 * NZ + ZV_R + h * HD, tid);
        } else {
            if (wave == 0) { const ChunkGates cg = chunk_gates(gates, row0, h, P->in[I_MFB][l * NH + h], P->in[I_MIB][l * NH + h], lane);
                float amax = fmaxf(cg.a0, cg.a1);
#pragma unroll
                for (int o = 1; o < 64; o <<= 1) amax = fmaxf(amax, __shfl_xor(amax, o));
                wj[2 * lane] = kscale * __expf(cg.a0 - amax); wj[2 * lane + 1] = kscale * __expf(cg.a1 - amax);
                if (lane == 0) { MS[(size_t)(bh * 32 + n) * 4 + 0] = cg.bL + amax; MS[(size_t)(bh * 32 + n) * 4 + 1] = cg.bL; } }
            __syncthreads();
            { const int c = (tid & 3) * 32; const float w = wj[row]; const u32x4* s = (const u32x4*)(z + (size_t)(row0 + row) * NZ + ZK_M + h * HD + c); LAS u32x4* d = (LAS u32x4*)(Kt + row * TS + c);
#pragma unroll
                for (int q = 0; q < 4; ++q) { const u32x4 v = s[q]; u32x4 o; o.x = pk2(bflo(v.x) * w, bfhi(v.x) * w); o.y = pk2(bflo(v.y) * w, bfhi(v.y) * w); o.z = pk2(bflo(v.z) * w, bfhi(v.z) * w); o.w = pk2(bflo(v.w) * w, bfhi(v.w) * w); d[q] = o; } }
            tile_load(Vt, z + (size_t)row0 * NZ + ZV_M + h * HD, tid);
        }
        __syncthreads();
        { f32x4 acc[8];
#pragma unroll
            for (int nt = 0; nt < 8; ++nt) acc[nt] = (f32x4){0.f, 0.f, 0.f, 0.f};
            const int d0 = 16 * wave;
#pragma unroll
            for (int ks = 0; ks < 4; ++ks) { const bf16x8 A = frag_tr(Kt, 32 * ks, d0, lane);
#pragma unroll
                for (int nt = 0; nt < 8; ++nt) { const bf16x8 B = frag_tr(Vt, 32 * ks, 16 * nt, lane); acc[nt] = MFMA16(A, B, acc[nt]); } }
            float* kv = KV + ((size_t)(kind * 16 + bh) * 32 + n) * 16384; const int g = lane >> 4, i = lane & 15;
#pragma unroll
            for (int nt = 0; nt < 8; ++nt)
#pragma unroll
                for (int r = 0; r < 4; ++r) kv[(d0 + 4 * g + r) * 128 + 16 * nt + i] = acc[nt][r];
            if (kind == 1 && tid < 128) { float sacc = 0.f; for (int j = 0; j < 128; ++j) sacc += bf2f(Kt[j * TS + tid]); NB[(size_t)(bh * 32 + n) * 128 + tid] = sacc; }
        }
    }
}

__device__ __forceinline__ void fox_block(Frame& F, int l, int bh, int qb, const KArgs P, unsigned char* ws, int tid, int lane, int wave) {
    const bf16_t* z = (const bf16_t*)(ws + WS_Z); bf16_t* y = (bf16_t*)(ws + WS_Y); const float* pref = (const float*)(ws + WS_PREF);
    LAS bf16_t* Kt = (LAS bf16_t*)F.lds; LAS bf16_t* Vt = Kt + 128 * TS; LAS float* Fj = (LAS float*)(F.lds + 2 * TILE_B);
    const int b = bh >> 2, h = bh & 3, g = lane >> 4, il = 16 * wave + (lane & 15), irow = qb * 128 + il; const size_t grow = (size_t)b * SEQ + irow;
    bf16x8 qf[4];
#pragma unroll
    for (int ks = 0; ks < 4; ++ks) qf[ks] = *(const bf16x8*)(z + grow * NZ + ZQ_F + h * HD + 32 * ks + 8 * g);
    const float F2i = pref[(size_t)bh * SEQ + irow];
    float mi = -1.0e30f, li = 0.f; f32x4 o[8];
#pragma unroll
    for (int mt = 0; mt < 8; ++mt) o[mt] = (f32x4){0.f, 0.f, 0.f, 0.f};
    const int lrow = tid >> 2, lc = (tid & 3) * 32;
    u32x4 pk[4], pv[4];
    { const u32x4* sk = (const u32x4*)(z + ((size_t)b * SEQ + lrow) * NZ + ZK_F + h * HD + lc); const u32x4* sv = (const u32x4*)(z + ((size_t)b * SEQ + lrow) * NZ + ZV_F + h * HD + lc);
#pragma unroll
        for (int q = 0; q < 4; ++q) { pk[q] = sk[q]; pv[q] = sv[q]; } }
    for (int kt = 0; kt <= qb; ++kt) {
        __syncthreads();
        { LAS u32x4* dk = (LAS u32x4*)(Kt + lrow * TS + lc); LAS u32x4* dv = (LAS u32x4*)(Vt + lrow * TS + lc);
#pragma unroll
            for (int q = 0; q < 4; ++q) { dk[q] = pk[q]; dv[q] = pv[q]; } }
        if (tid < 128) Fj[tid] = pref[(size_t)bh * SEQ + kt * 128 + tid];
        __syncthreads();
        if (kt < qb) { const u32x4* sk = (const u32x4*)(z + ((size_t)b * SEQ + (kt + 1) * 128 + lrow) * NZ + ZK_F + h * HD + lc); const u32x4* sv = (const u32x4*)(z + ((size_t)b * SEQ + (kt + 1) * 128 + lrow) * NZ + ZV_F + h * HD + lc);
#pragma unroll
            for (int q = 0; q < 4; ++q) { pk[q] = sk[q]; pv[q] = sv[q]; } }
        f32x4 st[8]; float mx = -INFINITY;
#pragma unroll
        for (int mt = 0; mt < 8; ++mt) { f32x4 a = (f32x4){0.f, 0.f, 0.f, 0.f};
#pragma unroll
            for (int ks = 0; ks < 4; ++ks) a = MFMA16(frag_row(Kt, 16 * mt + (lane & 15), 32 * ks + 8 * g), qf[ks], a);
            const f32x4 fj = *(const LAS f32x4*)(Fj + 16 * mt + 4 * g);
#pragma unroll
            for (int r = 0; r < 4; ++r) { float x = a[r] * 0.12751743074602467f + (F2i - fj[r]); if (kt == qb && (16 * mt + 4 * g + r) > il) x = -INFINITY; a[r] = x; mx = fmaxf(mx, x); }
            st[mt] = a; }
        mx = fmaxf(mx, __shfl_xor(mx, 16)); mx = fmaxf(mx, __shfl_xor(mx, 32));
        const float mn = fmaxf(mi, mx), alpha = __builtin_amdgcn_exp2f(mi - mn); float ps = 0.f;
#pragma unroll
        for (int mt = 0; mt < 8; ++mt)
#pragma unroll
            for (int r = 0; r < 4; ++r) { const float p = __builtin_amdgcn_exp2f(st[mt][r] - mn); st[mt][r] = p; ps += p; }
        ps += __shfl_xor(ps, 16); ps += __shfl_xor(ps, 32);
        li = li * alpha + ps; mi = mn;
        bf16x8 pf[4];
#pragma unroll
        for (int s2 = 0; s2 < 4; ++s2) pf[s2] = pack_acc(st[2 * s2], st[2 * s2 + 1]);
#pragma unroll
        for (int mt = 0; mt < 8; ++mt) { f32x4 a = o[mt] * alpha;
#pragma unroll
            for (int s2 = 0; s2 < 4; ++s2) a = MFMA16(frag_trp(Vt, s2, 16 * mt, lane), pf[s2], a);
            o[mt] = a; }
    }
    const float invl = 1.0f / li; float ss = 0.f;
#pragma unroll
    for (int mt = 0; mt < 8; ++mt) { o[mt] = o[mt] * invl; ss += (o[mt][0] * o[mt][0] + o[mt][1] * o[mt][1]) + (o[mt][2] * o[mt][2] + o[mt][3] * o[mt][3]); }
    ss += __shfl_xor(ss, 16); ss += __shfl_xor(ss, 32);
    const float rstd = __builtin_amdgcn_rsqf(ss * (1.f / HD) + EPS);
    const float* gn = P->in[I_HNG] + (size_t)l * DM + 512 + h * HD;
#pragma unroll
    for (int mt = 0; mt < 8; ++mt) { const int e0 = 16 * mt + 4 * g; const f32x4 gv = *(const f32x4*)(gn + e0);
        u32x2 w; w.x = pk2(o[mt][0] * rstd * gv[0], o[mt][1] * rstd * gv[1]); w.y = pk2(o[mt][2] * rstd * gv[2], o[mt][3] * rstd * gv[3]);
        *(u32x2*)(y + grow * DM + 512 + h * HD + e0) = w; }
}

__device__ __forceinline__ void phase_c2(Frame& F, int l) {
    PHASE_BEGIN();
    float* KV = (float*)(ws + WS_KV); float* NB = (float*)(ws + WS_NB); float* MS = (float*)(ws + WS_MS);
    for (int blk = F.vcu; blk < 2 * 16 * 8; blk += F.G) {
        const int kind = blk >> 7, bh = (blk >> 3) & 15, q4 = (blk & 7) * 512 + tid, h = bh & 3;
        f32x4* base = (f32x4*)(KV + (size_t)(kind * 16 + bh) * 32 * 16384) + q4;
        f32x4 kv[32];
#pragma unroll
        for (int n = 0; n < 32; ++n) kv[n] = base[(size_t)n * 4096];
        f32x4 S = (f32x4){0.f, 0.f, 0.f, 0.f};
        if (kind == 0) {
            const float dec = __builtin_amdgcn_exp2f(128.0f * __builtin_log2f(1.0f - __builtin_amdgcn_exp2f(-5.0f - (float)h)));
#pragma unroll
            for (int n = 0; n < 32; ++n) { base[(size_t)n * 4096] = S; S = S * dec + kv[n]; }
        } else {
            const bool donb = q4 < 32; f32x4* nb = (f32x4*)(NB + (size_t)bh * 32 * 128) + q4; f32x4 Nn = (f32x4){0.f, 0.f, 0.f, 0.f};
            const float* ms = MS + (size_t)bh * 32 * 4;
            float m = 0.f;
#pragma unroll
            for (int n = 0; n < 32; ++n) { const float mloc = ms[n * 4 + 0], bL = ms[n * 4 + 1];
                if (q4 == 0) MS[(size_t)(bh * 32 + n) * 4 + 2] = m;
                base[(size_t)n * 4096] = S;
                const float mn = fmaxf(bL + m, mloc), d0 = __expf(bL + m - mn), d1 = __expf(mloc - mn);
                S = S * d0 + kv[n] * d1;
                if (donb) { const f32x4 nv = nb[(size_t)n * 32]; nb[(size_t)n * 32] = Nn; Nn = Nn * d0 + nv * d1; }
                m = mn; }
        }
    }
    for (int it = F.vcu; it < 16 * 16; it += F.G) { const int bh = it >> 4, p = it & 15;
        fox_block(F, l, bh, p, P, ws, tid, lane, wave);
        fox_block(F, l, bh, 31 - p, P, ws, tid, lane, wave); }
}

__device__ __forceinline__ void phase_c3(Frame& F, int l) {
    PHASE_BEGIN();
    const bf16_t* z = (const bf16_t*)(ws + WS_Z); bf16_t* y = (bf16_t*)(ws + WS_Y); const float* gates = (const float*)(ws + WS_GATES);
    const float* KV = (const float*)(ws + WS_KV); const float* NB = (const float*)(ws + WS_NB); const float* MS = (const float*)(ws + WS_MS);
    LAS bf16_t* Kt = (LAS bf16_t*)F.lds; LAS bf16_t* Vt = Kt + 128 * TS; LAS bf16_t* St = Vt + 128 * TS;
    LAS float* aj = (LAS float*)(F.lds + 3 * TILE_B); LAS float* bj = aj + 128; LAS float* Mj = bj + 128; LAS float* npv = Mj + 128;
    const float kscale = 0.08838834764831845f;
    const int g = lane >> 4, il = 16 * wave + (lane & 15);
    for (int it = F.vcu; it < 2 * 16 * 32; it += F.G) {
        const int kind = it >> 9, bh = (it >> 5) & 15, n = it & 31, b = bh >> 2, h = bh & 3, row0 = b * SEQ + n * 128;
        const int qcol = (kind ? ZQ_M : ZQ_R) + h * HD, kcol = (kind ? ZK_M : ZK_R) + h * HD, vcol = (kind ? ZV_M : ZV_R) + h * HD;
        __syncthreads();
        tile_load(Kt, z + (size_t)row0 * NZ + kcol, tid); tile_load(Vt, z + (size_t)row0 * NZ + vcol, tid);
        { const int row = tid >> 2, c = (tid & 3) * 32; const f32x4* s = (const f32x4*)(KV + ((size_t)(kind * 16 + bh) * 32 + n) * 16384 + row * 128 + c); LAS u32x4* d = (LAS u32x4*)(St + row * TS + c);
#pragma unroll
            for (int q = 0; q < 4; ++q) { const f32x4 v0 = s[2 * q], v1 = s[2 * q + 1]; u32x4 o; o.x = pk2(v0[0], v0[1]); o.y = pk2(v0[2], v0[3]); o.z = pk2(v1[0], v1[1]); o.w = pk2(v1[2], v1[3]); d[q] = o; } }
        float mprev = 0.f;
        if (kind == 1) { mprev = MS[(size_t)(bh * 32 + n) * 4 + 2];
            if (wave == 0) { const ChunkGates cg = chunk_gates(gates, row0, h, P->in[I_MFB][l * NH + h], P->in[I_MIB][l * NH + h], lane);
                float incm = fmaxf(cg.a0, cg.a1);
#pragma unroll
                for (int o = 1; o < 64; o <<= 1) { const float t = __shfl_up(incm, o); if (lane >= o) incm = fmaxf(incm, t); }
                const float prev = __shfl_up(incm, 1); const float exm = lane == 0 ? -INFINITY : prev;
                aj[2 * lane] = cg.a0; aj[2 * lane + 1] = cg.a1; bj[2 * lane] = cg.b0; bj[2 * lane + 1] = cg.b1;
                Mj[2 * lane] = fmaxf(fmaxf(exm, cg.a0), mprev); Mj[2 * lane + 1] = fmaxf(incm, mprev); }
            if (tid >= 128 && tid < 256) npv[tid - 128] = NB[(size_t)(bh * 32 + n) * 128 + (tid - 128)]; }
        __syncthreads();
        const size_t grow = (size_t)row0 + il;
        bf16x8 qf[4];
#pragma unroll
        for (int ks = 0; ks < 4; ++ks) qf[ks] = *(const bf16x8*)(z + grow * NZ + qcol + 32 * ks + 8 * g);
        const float lg2g = __builtin_log2f(1.0f - __builtin_amdgcn_exp2f(-5.0f - (float)h));
        const float Mi = kind ? Mj[il] : 0.f;
        f32x4 st[8]; float rsum = 0.f;
#pragma unroll
        for (int mt = 0; mt < 8; ++mt) { f32x4 a = (f32x4){0.f, 0.f, 0.f, 0.f};
#pragma unroll
            for (int ks = 0; ks < 4; ++ks) a = MFMA16(frag_row(Kt, 16 * mt + (lane & 15), 32 * ks + 8 * g), qf[ks], a);
            const f32x4 av = kind ? *(const LAS f32x4*)(aj + 16 * mt + 4 * g) : (f32x4){0.f, 0.f, 0.f, 0.f};
#pragma unroll
            for (int r = 0; r < 4; ++r) { const int j = 16 * mt + 4 * g + r;
                const float w = kind ? __expf(av[r] - Mi) : __builtin_amdgcn_exp2f((float)(il - j) * lg2g);
                const float p = j <= il ? a[r] * kscale * w : 0.f; a[r] = p; rsum += p; }
            st[mt] = a; }
        bf16x8 pf[4];
#pragma unroll
        for (int s2 = 0; s2 < 4; ++s2) pf[s2] = pack_acc(st[2 * s2], st[2 * s2 + 1]);
        const float cinter = kind ? __expf(mprev - Mi) : __builtin_amdgcn_exp2f((float)(il + 1) * lg2g);
        f32x4 o[8];
#pragma unroll
        for (int mt = 0; mt < 8; ++mt) { f32x4 a2 = (f32x4){0.f, 0.f, 0.f, 0.f};
#pragma unroll
            for (int ks = 0; ks < 4; ++ks) a2 = MFMA16(frag_tr(St, 32 * ks, 16 * mt, lane), qf[ks], a2);
            f32x4 a = a2 * cinter;
#pragma unroll
            for (int s2 = 0; s2 < 4; ++s2) a = MFMA16(frag_trp(Vt, s2, 16 * mt, lane), pf[s2], a);
            o[mt] = a; }
        if (kind == 1) {
            float qn = 0.f;
#pragma unroll
            for (int ks = 0; ks < 4; ++ks) { const u32x4 qw = __builtin_bit_cast(u32x4, qf[ks]); const f32x4 n0 = *(const LAS f32x4*)(npv + 32 * ks + 8 * g), n1 = *(const LAS f32x4*)(npv + 32 * ks + 8 * g + 4);
                qn += bflo(qw.x) * n0[0] + bfhi(qw.x) * n0[1] + bflo(qw.y) * n0[2] + bfhi(qw.y) * n0[3] + bflo(qw.z) * n1[0] + bfhi(qw.z) * n1[1] + bflo(qw.w) * n1[2] + bfhi(qw.w) * n1[3]; }
            qn += __shfl_xor(qn, 16); qn += __shfl_xor(qn, 32); rsum += __shfl_xor(rsum, 16); rsum += __shfl_xor(rsum, 32);
            const float den = fmaxf(fabsf(rsum + cinter * qn), __expf(-bj[il] - Mi)), iden = 1.0f / den;
#pragma unroll
            for (int mt = 0; mt < 8; ++mt) { const u32x2 gw2 = *(const u32x2*)(z + grow * NZ + ZO_M + h * HD + 16 * mt + 4 * g);
                o[mt][0] *= iden * sigmoidf_(bflo(gw2.x)); o[mt][1] *= iden * sigmoidf_(bfhi(gw2.x)); o[mt][2] *= iden * sigmoidf_(bflo(gw2.y)); o[mt][3] *= iden * sigmoidf_(bfhi(gw2.y)); }
        }
        float ss = 0.f;
#pragma unroll
        for (int mt = 0; mt < 8; ++mt) ss += (o[mt][0] * o[mt][0] + o[mt][1] * o[mt][1]) + (o[mt][2] * o[mt][2] + o[mt][3] * o[mt][3]);
        ss += __shfl_xor(ss, 16); ss += __shfl_xor(ss, 32);
        const float rstd = __builtin_amdgcn_rsqf(ss * (1.f / HD) + EPS);
        const int ycol = (kind ? 1024 : 0) + h * HD; const float* gn = P->in[I_HNG] + (size_t)l * DM + ycol;
#pragma unroll
        for (int mt = 0; mt < 8; ++mt) { const int e0 = 16 * mt + 4 * g; const f32x4 gv = *(const f32x4*)(gn + e0);
            float v0 = o[mt][0] * rstd * gv[0], v1 = o[mt][1] * rstd * gv[1], v2 = o[mt][2] * rstd * gv[2], v3 = o[mt][3] * rstd * gv[3];
            if (kind == 0) { const u32x2 gw2 = *(const u32x2*)(z + grow * NZ + ZG_R + h * HD + e0); v0 *= siluf_(bflo(gw2.x)); v1 *= siluf_(bfhi(gw2.x)); v2 *= siluf_(bflo(gw2.y)); v3 *= siluf_(bfhi(gw2.y)); }
            u32x2 w; w.x = pk2(v0, v1); w.y = pk2(v2, v3); *(u32x2*)(y + grow * DM + ycol + e0) = w; }
    }
}

__device__ __forceinline__ void phase_router(Frame& F, int l) {
    PHASE_BEGIN();
    const float* x1 = (const float*)(ws + WS_X1);
    bf16_t* hb = (bf16_t*)(ws + WS_HB);
    const bf16_t* rwh = (const bf16_t*)(ws + WS_RWB) + (size_t)l * 2 * 48 * DM; const bf16_t* rwl = rwh + (size_t)48 * DM;
    const float* g2 = P->in[I_N2G] + (size_t)l * DM;
    unsigned* gcnt = (unsigned*)(ws + WS_CTL) + CW_CNT + l * 64;
    unsigned* route = (unsigned*)(ws + WS_ROUTE);
    int* toklist = (int*)(ws + WS_TOK);
    LAS unsigned* lcnt = (LAS unsigned*)F.lds; LAS unsigned* lbase = lcnt + 32; LAS float* ssqp = (LAS float*)(lbase + 32);
    LAS float* lg = ssqp + 128;
    const int rg = wave & 3, kh = wave >> 2, i = lane & 15, g = lane >> 4;
    for (int bt = F.vcu; bt < T / 64; bt += F.G) {
        const int m = bt * 64 + 16 * rg + i;
        const float* xr = x1 + (size_t)m * DM + kh * 1024 + 8 * g;
        __syncthreads();
        if (tid < 32) lcnt[tid] = 0u;
        float ss = 0.f;
#pragma unroll 8
        for (int ks = 0; ks < 32; ++ks) { const f32x4 a = *(const f32x4*)(xr + 32 * ks), b = *(const f32x4*)(xr + 32 * ks + 4);
            ss += (a.x * a.x + a.y * a.y) + (a.z * a.z + a.w * a.w) + (b.x * b.x + b.y * b.y) + (b.z * b.z + b.w * b.w); }
        ss += __shfl_xor(ss, 16); ss += __shfl_xor(ss, 32);
        if (g == 0) ssqp[kh * 64 + 16 * rg + i] = ss;
        __syncthreads();
        const float rstd = __builtin_amdgcn_rsqf((ssqp[16 * rg + i] + ssqp[64 + 16 * rg + i]) * (1.f / DM) + EPS);
        f32x4 acc[3];
#pragma unroll
        for (int nt = 0; nt < 3; ++nt) acc[nt] = (f32x4){0.f, 0.f, 0.f, 0.f};
        const float* gr = g2 + kh * 1024 + 8 * g; bf16_t* ho = hb + (size_t)m * DM + kh * 1024 + 8 * g;
        const bf16_t* wh = rwh + (size_t)i * DM + kh * 1024 + 8 * g; const bf16_t* wl = rwl + (size_t)i * DM + kh * 1024 + 8 * g;
#pragma unroll 2
        for (int ks = 0; ks < 32; ++ks) {
            const f32x4 a = *(const f32x4*)(xr + 32 * ks), b = *(const f32x4*)(xr + 32 * ks + 4), ga = *(const f32x4*)(gr + 32 * ks), gb = *(const f32x4*)(gr + 32 * ks + 4);
            const f32x4 ha = a * rstd * ga, hb4 = b * rstd * gb;
            u32x4 hi; hi.x = pk2(ha.x, ha.y); hi.y = pk2(ha.z, ha.w); hi.z = pk2(hb4.x, hb4.y); hi.w = pk2(hb4.z, hb4.w);
            u32x4 lo; lo.x = pk2(ha.x - bflo(hi.x), ha.y - bfhi(hi.x)); lo.y = pk2(ha.z - bflo(hi.y), ha.w - bfhi(hi.y)); lo.z = pk2(hb4.x - bflo(hi.z), hb4.y - bfhi(hi.z)); lo.w = pk2(hb4.z - bflo(hi.w), hb4.w - bfhi(hi.w));
            *(u32x4*)(ho + 32 * ks) = hi;
            const bf16x8 Ah = __builtin_bit_cast(bf16x8, hi), Al = __builtin_bit_cast(bf16x8, lo);
#pragma unroll
            for (int nt = 0; nt < 3; ++nt) { const bf16x8 Wh = *(const bf16x8*)(wh + (size_t)16 * nt * DM + 32 * ks), Wl = *(const bf16x8*)(wl + (size_t)16 * nt * DM + 32 * ks);
                acc[nt] = MFMA16(Ah, Wh, acc[nt]); acc[nt] = MFMA16(Ah, Wl, acc[nt]); acc[nt] = MFMA16(Al, Wh, acc[nt]); }
        }
#pragma unroll
        for (int nt = 0; nt < 3; ++nt)
#pragma unroll
            for (int r = 0; r < 4; ++r) lg[(kh * 64 + 16 * rg + 4 * g + r) * 48 + 16 * nt + i] = acc[nt][r];
        __syncthreads();
        unsigned e0 = 0, e1 = 0, p0 = 0, p1 = 0; float w0 = 0.f, w1 = 0.f;
        if (tid < 64) {
            float L[36];
#pragma unroll
            for (int c4 = 0; c4 < 9; ++c4) { const f32x4 u = *(const LAS f32x4*)(lg + tid * 48 + 4 * c4), v = *(const LAS f32x4*)(lg + (64 + tid) * 48 + 4 * c4);
                L[4 * c4] = u.x + v.x; L[4 * c4 + 1] = u.y + v.y; L[4 * c4 + 2] = u.z + v.z; L[4 * c4 + 3] = u.w + v.w; }
            float gl[4]; float gmax = -INFINITY; int gsel = 0;
#pragma unroll
            for (int q = 0; q < 4; ++q) { gl[q] = L[q] + P->in[I_BRG][l * 4 + q]; if (gl[q] > gmax) { gmax = gl[q]; gsel = q; } }
            float gsum = 0.f;
#pragma unroll
            for (int q = 0; q < 4; ++q) gsum += __expf(gl[q] - gmax);
            const float gp = 1.0f / gsum;
            float el[8];
#pragma unroll
            for (int j = 0; j < 8; ++j) { const float c0 = L[4 + j], c1 = L[12 + j], c2 = L[20 + j], c3 = L[28 + j];
                el[j] = (gsel == 0 ? c0 : (gsel == 1 ? c1 : (gsel == 2 ? c2 : c3))) + P->in[I_BRE][l * 32 + gsel * 8 + j]; }
            float m0 = -INFINITY; int i0 = 0;
#pragma unroll
            for (int j = 0; j < 8; ++j) if (el[j] > m0) { m0 = el[j]; i0 = j; }
            float m1 = -INFINITY; int i1 = 0;
#pragma unroll
            for (int j = 0; j < 8; ++j) if (j != i0 && el[j] > m1) { m1 = el[j]; i1 = j; }
            const float r = __expf(m1 - m0); w0 = gp / (1.0f + r); w1 = gp * r / (1.0f + r);
            e0 = (unsigned)(gsel * 8 + i0); e1 = (unsigned)(gsel * 8 + i1);
            p0 = atomicAdd((unsigned*)(lcnt + e0), 1u); p1 = atomicAdd((unsigned*)(lcnt + e1), 1u);
        }
        __syncthreads();
        if (tid < 32) lbase[tid] = __hip_atomic_fetch_add(gcnt + tid, lcnt[tid], __ATOMIC_RELAXED, __HIP_MEMORY_SCOPE_AGENT);
        __syncthreads();
        if (tid < 64) { const int mr = bt * 64 + tid; p0 += lbase[e0]; p1 += lbase[e1];
            toklist[(size_t)e0 * TOKCAP + p0] = mr; toklist[(size_t)e1 * TOKCAP + p1] = mr;
            u32x4 a; a.x = e0; a.y = p0; a.z = e1; a.w = p1; *(u32x4*)(route + (size_t)mr * 8) = a;
            u32x2 b; b.x = __builtin_bit_cast(unsigned, w0); b.y = __builtin_bit_cast(unsigned, w1); *(u32x2*)(route + (size_t)mr * 8 + 4) = b; }
    }
}

constexpr int PPL = 9, NPH = 2 + PPL * DEPTH;
__global__ void __launch_bounds__(NWAVES * 64, 2) hybrid_fwd(Params p) {
    extern __shared__ __attribute__((aligned(16))) unsigned char lds_raw[];
    Frame F;
    F.lds = (LAS unsigned char*)lds_raw;
    F.G = gridDim.x; { const int bx = blockIdx.x; F.vcu = (F.G % 8 == 0) ? (bx % 8) * (F.G / 8) + bx / 8 : bx; }
    for (int u = threadIdx.x; u < (LDS_BYTES - LDSCTL_OFF) / 4; u += NWAVES * 64) ((LAS unsigned*)(F.lds + LDSCTL_OFF))[u] = 0u;
    __syncthreads();
    const int lo = p.ph_lo, hi = p.ph_hi;
    XcdBarrier bar; bar.bar = (unsigned*)(p.ws + WS_CTL) + CW_BAR; bar.x = 0; bar.st = nullptr;
    if (hi - lo > 1) bar = xcd_barrier_post((unsigned*)(p.ws + WS_CTL) + CW_BAR, (volatile LAS unsigned*)(F.lds + LDSCTL_OFF + 32));
#define IN(k) (lo <= (k) && (k) < hi)
#ifdef PROBE_K
    unsigned long long pr_t0 = __builtin_amdgcn_s_memrealtime();
#define SEAM(k) do { if (IN(k) && IN((k) + 1)) xcd_barrier(bar); { const int _k = (k); const bool _hit = (PROBE_K == 100) ? (_k == 0) : ((PROBE_K == 101) ? false : (_k >= 1 && (_k - 1) % PPL == PROBE_K)); \
        const unsigned long long _t1 = __builtin_amdgcn_s_memrealtime(); if (_hit) { const unsigned long long _d = 4ull * (_t1 - pr_t0); while (__builtin_amdgcn_s_memrealtime() - _t1 < _d) __builtin_amdgcn_s_sleep(8); } \
        pr_t0 = __builtin_amdgcn_s_memrealtime(); } } while (0)
#else
#define SEAM(k) do { if (IN(k) && IN((k) + 1)) xcd_barrier(bar); } while (0)
#endif

    if (IN(0)) { phase_w(F); }
    SEAM(0);
    for (int l = 0; l < DEPTH; ++l) {
        const int pb = 1 + PPL * l;
        if (IN(pb + 0)) {
            const KArgs P = kargs();
            if (l == 0) phase_norm1<0>(F, l, P->in[I_X], nullptr); else phase_norm1<1>(F, l, (const float*)(P->ws + WS_X1), P->out);
        }
        SEAM(pb + 0);
        if (IN(pb + 1)) {
            const KArgs P = kargs(); unsigned char* const ws = P->ws;
            pg8::SchedStatic S; S.o.init(T, NZ, F.G, (int)blockIdx.x); S.Bt = (const char*)(ws + WS_WIN + l * SZ_WIN); S.tstepB = (size_t)256 * DM * 2;
            pg8::EpiBf16 E{(bf16_t*)(ws + WS_Z), NZ};
            pg8::gemm_phase(F.lds, (const char*)(ws + WS_HB), DM, S, E);
        }
        SEAM(pb + 1);
#ifdef NAIVE_MIX
        if (IN(pb + 2)) { phase_prep(F, l); }
        SEAM(pb + 2);
        if (IN(pb + 3)) { phase_mix_naive(F, l); }
        SEAM(pb + 3);
        SEAM(pb + 4);
#else
        if (IN(pb + 2)) { phase_c1(F, l); }
        SEAM(pb + 2);
        if (IN(pb + 3)) { phase_c2(F, l); }
        SEAM(pb + 3);
        if (IN(pb + 4)) { phase_c3(F, l); }
        SEAM(pb + 4);
#endif
        if (IN(pb + 5)) {
            const KArgs P = kargs(); unsigned char* const ws = P->ws;
            const float* xl = l == 0 ? P->in[I_X] : (const float*)P->out;
            pg8::SchedStatic S; S.o.init(T, DM, F.G, (int)blockIdx.x); S.Bt = (const char*)(ws + WS_WOUT + l * SZ_WOUT); S.tstepB = (size_t)256 * DM * 2;
            pg8::EpiResF32 E{xl, (float*)(ws + WS_X1), DM};
            pg8::gemm_phase(F.lds, (const char*)(ws + WS_Y), DM, S, E);
        }
        SEAM(pb + 5);
        if (IN(pb + 6)) { phase_router(F, l); }
        SEAM(pb + 6);
        if (IN(pb + 7)) {
            const MoeTab mt = moe_tab(F, l);
            const KArgs P = kargs(); unsigned char* const ws = P->ws;
            pg8::SchedMoe<true> S; S.G = F.G; S.c = (int)blockIdx.x; S.MT = mt.tstart[NE]; S.tstart = mt.tstart; S.cnt = mt.cnt; S.toklist = (const int*)(ws + WS_TOK);
            S.Wt = (const char*)(ws + WS_WGU + l * SZ_WGU); S.estride = (size_t)2048 * DM * 2; S.tstepB = (size_t)256 * DM * 2;
            pg8::EpiGateUp E{(bf16_t*)(ws + WS_HH)};
            pg8::gemm_phase(F.lds, (const char*)(ws + WS_HB), DM, S, E);
        }
        SEAM(pb + 7);
        if (IN(pb + 8)) {
            const MoeTab mt = moe_tab(F, l);
            const KArgs P = kargs(); unsigned char* const ws = P->ws;
            pg8::SchedMoe<false> S; S.G = F.G; S.c = (int)blockIdx.x; S.MT = mt.tstart[NE]; S.tstart = mt.tstart; S.cnt = mt.cnt; S.toklist = nullptr;
            S.Wt = (const char*)(ws + WS_WD + l * SZ_WD); S.estride = (size_t)DM * DFF * 2; S.tstepB = (size_t)256 * DFF * 2;
            pg8::EpiBf16 E{(bf16_t*)(ws + WS_Z), DM};
            pg8::gemm_phase(F.lds, (const char*)(ws + WS_HH), DFF, S, E);
        }
        SEAM(pb + 8);
    }
    if (IN(NPH - 1)) { const KArgs P = kargs(); phase_norm1<2>(F, DEPTH, (const float*)(P->ws + WS_X1), P->out); }
#undef IN
#undef SEAM
}

extern "C" void kernel_launch(void* const* d_in, const int* in_sizes, int n_in, void* d_out, int out_size, void* d_ws, size_t ws_size, hipStream_t stream) {
    static int grid = 0;
    if (grid == 0) {
        if (n_in != 20 || out_size != T * DM || ws_size < WS_END) { fprintf(stderr, "kernel_launch: unexpected shapes (n_in %d out %d ws %zu need %zu)\n", n_in, out_size, ws_size, (size_t)WS_END); grid = -1; return; }
        int dev = 0, cus = 0, per_cu = 0;
        if (hipGetDevice(&dev) != hipSuccess || hipDeviceGetAttribute(&cus, hipDeviceAttributeMultiprocessorCount, dev) != hipSuccess) { grid = -1; return; }
        if (hipFuncSetAttribute((const void*)hybrid_fwd, hipFuncAttributeMaxDynamicSharedMemorySize, LDS_BYTES) != hipSuccess) { fprintf(stderr, "kernel_launch: hipFuncSetAttribute failed\n"); grid = -1; return; }
        if (hipOccupancyMaxActiveBlocksPerMultiprocessor(&per_cu, (const void*)hybrid_fwd, NWAVES * 64, LDS_BYTES) != hipSuccess || per_cu < 1)
            fprintf(stderr, "kernel_launch: note: occupancy query reports %d workgroups per CU\n", per_cu);
        (void)hipGetLastError();
        grid = cus;
    }
    if (grid < 0) return;
    if (hipMemsetAsync((char*)d_ws + WS_CTL, 0, CTL_ZERO_BYTES, stream) != hipSuccess) return;
    Params a{};
    for (int i = 0; i < 20; ++i) a.in[i] = (const float*)d_in[i];
    a.out = (float*)d_out; a.ws = (unsigned char*)d_ws;
#if MK_PER_PHASE
    for (int ph = 0; ph < NPH; ++ph) { a.ph_lo = ph; a.ph_hi = ph + 1; hipLaunchKernelGGL(hybrid_fwd, dim3(grid), dim3(NWAVES * 64), LDS_BYTES, stream, a); }
#else
    a.ph_lo = 0; a.ph_hi = NPH;
    hipLaunchKernelGGL(hybrid_fwd, dim3(grid), dim3(NWAVES * 64), LDS_BYTES, stream, a);
#endif
    const hipError_t le = hipPeekAtLastError();
    if (le != hipSuccess) fprintf(stderr, "kernel_launch: launch failed: %s\n", hipGetErrorName(le));
}
```
